# Optimizing an MI355X kernel written in HIP

```python
import jax, jax.numpy as jnp
from jax import lax
import numpy as np

D_MODEL = 1024
BATCH = 16
SEQ = 2048
DEPTH = 4

CTX_LEN = 256
GRID_W = 64
EXPAND = 2
MIX_WIDTH = EXPAND * D_MODEL
HGRN_WIDTH = MIX_WIDTH // 2
FOURIER_WIDTH = MIX_WIDTH - HGRN_WIDTH
HGRN_HEAD_DIM = 128
HGRN_HEADS = HGRN_WIDTH // HGRN_HEAD_DIM
FOURIER_GROUPS = 4
FOURIER_GROUP_DIM = FOURIER_WIDTH // FOURIER_GROUPS
IN_WIDTH = 5 * HGRN_WIDTH + 2 * FOURIER_WIDTH
CHUNK = 32
POS_BASE = 10000.0
EPS = 1e-6
F_MIN = 1e-6

kernel_name = "hybrid_hgrn2_fnet_prefix"

F32 = jnp.float32


def rmsnorm(x, w):
    xf = x.astype(F32)
    y = xf * lax.rsqrt(jnp.mean(xf * xf, axis=-1, keepdims=True) + EPS)
    return (y * w.astype(F32)).astype(x.dtype)


def sincos_2d(length, dim):
    rows = length // GRID_W
    row = jnp.repeat(jnp.arange(rows, dtype=F32), GRID_W)
    col = jnp.tile(jnp.arange(GRID_W, dtype=F32), rows)
    quarter = dim // 4
    omega = jnp.power(POS_BASE, -jnp.arange(quarter, dtype=F32) / quarter)

    def axis_code(p):
        ang = p[:, None] * omega[None, :]
        return jnp.concatenate([jnp.sin(ang), jnp.cos(ang)], axis=-1)

    return jnp.concatenate([axis_code(row), axis_code(col)], axis=-1)


def to_heads(t):
    return t.reshape(t.shape[:-1] + (HGRN_HEADS, HGRN_HEAD_DIM))


def split_proj(p):
    a = HGRN_WIDTH
    return jnp.split(p, [a, 2 * a, 3 * a, 4 * a, 5 * a, 5 * a + FOURIER_WIDTH], axis=-1)


def layer_lower_bounds(lower_bounds):
    p = jax.nn.softmax(lower_bounds.astype(F32), axis=1)
    return jnp.cumsum(p, axis=1) - p[:, :1]


def forget_gate(z, lb):
    z = z.astype(F32)
    lb = lb.reshape(HGRN_HEADS, HGRN_HEAD_DIM)
    k = (1.0 - lb) * jax.nn.sigmoid(-z)
    log_f = jnp.log(jnp.maximum(1.0 - k, F_MIN))
    return k, log_f


def chunk_scan(q, k, v, log_f, s0):
    b_, length, h, _ = q.shape
    dv = v.shape[-1]
    n = length // CHUNK

    def blocks(t):
        return t.reshape(b_, n, CHUNK, h, t.shape[-1]).transpose(1, 0, 3, 2, 4)

    tri = jnp.tril(jnp.ones((CHUNK, CHUNK), dtype=bool))[:, :, None]

    def step(state, inp):
        qc, kc, vc, gc = inp
        bcum = jnp.cumsum(gc, axis=2)
        o_inter = jnp.einsum("bhtd,bhde->bhte", qc * jnp.exp(bcum), state)
        rel = jnp.where(tri, bcum[:, :, :, None, :] - bcum[:, :, None, :, :], 0.0)
        decay = jnp.where(tri, jnp.exp(rel), 0.0)
        scores = jnp.einsum("bhtd,bhsd,bhtsd->bhts", qc, kc, decay)
        o_intra = jnp.einsum("bhts,bhse->bhte", scores, vc)
        b_end = bcum[:, :, -1:, :]
        state = state * jnp.exp(b_end)[:, :, 0, :, None] + jnp.einsum(
            "bhsd,bhse->bhde", kc * jnp.exp(b_end - bcum), vc)
        return state, o_inter + o_intra

    s_final, o = lax.scan(step, s0, (blocks(q), blocks(k), blocks(v), blocks(log_f)))
    return o.transpose(1, 0, 3, 2, 4).reshape(b_, length, h, dv), s_final


def final_state(k, v, log_f):
    bcum = jnp.cumsum(log_f, axis=1)
    w = k * jnp.exp(bcum[:, -1:] - bcum)
    return jnp.einsum("bthd,bthe->bhde", w, v)


def fourier_mix(u, w_four, b_four):
    b_, length, _ = u.shape
    ug = u.astype(F32).reshape(b_, length, FOURIER_GROUPS, FOURIER_GROUP_DIM)
    spec = jnp.fft.fftn(ug, axes=(1, 3), norm="ortho").real
    y = jnp.einsum("blgc,gcd->blgd", spec, w_four.astype(F32)).reshape(b_, length, FOURIER_WIDTH)
    return (y + b_four.astype(F32)).astype(u.dtype)


def mix_stream(h, w_in, lb_f, lb_b, s0_f, s0_b, hn_w, w_four, b_four, w_out):
    p = h @ w_in
    i_in, z_f, z_b, q_in, gate_a, u_f, gate_f = split_proj(p)
    v = to_heads(i_in).astype(F32)
    q = jax.nn.silu(to_heads(q_in).astype(F32))
    k_f, g_f = forget_gate(to_heads(z_f), lb_f)
    k_b, g_b = forget_gate(to_heads(z_b), lb_b)
    o_f, s_f = chunk_scan(q, k_f, v, g_f, s0_f)
    flip = lambda t: jnp.flip(t, axis=1)
    o_b, s_b = chunk_scan(flip(q), flip(k_b), flip(v), flip(g_b), s0_b)
    o = o_f + flip(o_b)
    o = o * lax.rsqrt(jnp.mean(o * o, axis=-1, keepdims=True) + EPS)
    o = o * hn_w.astype(F32).reshape(HGRN_HEADS, HGRN_HEAD_DIM)
    y_a = o.reshape(h.shape[:-1] + (HGRN_WIDTH,)).astype(h.dtype) * jax.nn.silu(gate_a)
    y_f = fourier_mix(u_f, w_four, b_four) * jax.nn.silu(gate_f)
    out = jnp.concatenate([y_a, y_f], axis=-1) @ w_out
    return out, s_f, s_b


def context_final_states(h, w_in, lb_f, lb_b):
    p = h @ w_in[:, :3 * HGRN_WIDTH]
    i_in, z_f, z_b = jnp.split(p, [HGRN_WIDTH, 2 * HGRN_WIDTH], axis=-1)
    v = to_heads(i_in).astype(F32)
    k_f, g_f = forget_gate(to_heads(z_f), lb_f)
    k_b, g_b = forget_gate(to_heads(z_b), lb_b)
    flip = lambda t: jnp.flip(t, axis=1)
    return final_state(k_f, v, g_f), final_state(flip(k_b), flip(v), flip(g_b))


def setup_inputs(seed: int = 0) -> dict:
    key = jax.random.key(seed)
    ks = jax.random.split(key, 14)
    d = D_MODEL
    nrm = lambda k, s: jax.random.normal(k, s, dtype=F32)
    return {
        "x": nrm(ks[0], (BATCH, SEQ, d)),
        "c": nrm(ks[1], (BATCH, d)),
        "ctx": nrm(ks[2], (BATCH, CTX_LEN, d)),
        "c_ctx": nrm(ks[3], (d,)),
        "norm_w": 1.0 + 0.02 * nrm(ks[4], (DEPTH, d)),
        "w_ada": 0.5 * d ** -0.5 * nrm(ks[5], (DEPTH, d, 3 * d)),
        "b_ada": 0.01 * nrm(ks[6], (DEPTH, 3 * d)),
        "w_in": d ** -0.5 * nrm(ks[7], (DEPTH, d, IN_WIDTH)),
        "lower_bounds": 1.0 + 0.1 * nrm(ks[8], (2, DEPTH, HGRN_WIDTH)),
        "hgrn_norm_w": 1.0 + 0.02 * nrm(ks[9], (DEPTH, HGRN_WIDTH)),
        "w_fourier": FOURIER_GROUP_DIM ** -0.5 * nrm(ks[10], (DEPTH, FOURIER_GROUPS, FOURIER_GROUP_DIM, FOURIER_GROUP_DIM)),
        "b_fourier": 0.01 * nrm(ks[11], (DEPTH, FOURIER_WIDTH)),
        "w_out": MIX_WIDTH ** -0.5 * nrm(ks[12], (DEPTH, MIX_WIDTH, d)),
        "final_norm_w": 1.0 + 0.02 * nrm(ks[13], (d,)),
    }


def reference(x, c, ctx, c_ctx, norm_w, w_ada, b_ada, w_in, lower_bounds, hgrn_norm_w,
              w_fourier, b_fourier, w_out, final_norm_w):
    b_, length, d = x.shape
    x = x + sincos_2d(length, d).astype(x.dtype)[None]
    lbs = layer_lower_bounds(lower_bounds)
    sc = jax.nn.silu(c)
    scc = jax.nn.silu(c_ctx)
    zero = jnp.zeros((b_, HGRN_HEADS, HGRN_HEAD_DIM, HGRN_HEAD_DIM), dtype=F32)
    for l in range(DEPTH):
        shift, scale, gate = jnp.split(sc @ w_ada[l] + b_ada[l], 3, axis=-1)
        shift_c, scale_c, gate_c = jnp.split(scc @ w_ada[l] + b_ada[l], 3, axis=-1)
        hc = rmsnorm(ctx, norm_w[l]) * (1.0 + scale_c) + shift_c
        if l < DEPTH - 1:
            out_c, s_f, s_b = mix_stream(hc, w_in[l], lbs[0, l], lbs[1, l], zero, zero,
                                         hgrn_norm_w[l], w_fourier[l], b_fourier[l], w_out[l])
        else:
            s_f, s_b = context_final_states(hc, w_in[l], lbs[0, l], lbs[1, l])
        hx = rmsnorm(x, norm_w[l]) * (1.0 + scale[:, None]) + shift[:, None]
        out_x, _, _ = mix_stream(hx, w_in[l], lbs[0, l], lbs[1, l], s_f, s_b,
                                 hgrn_norm_w[l], w_fourier[l], b_fourier[l], w_out[l])
        x = x + gate[:, None] * out_x
        if l < DEPTH - 1:
            ctx = ctx + gate_c * out_c
    return rmsnorm(x, final_norm_w)
```

```cpp
#include <hip/hip_runtime.h>
#include <hip/hip_cooperative_groups.h>
#include <cstdio>
namespace cg = cooperative_groups;

#define LAS __attribute__((address_space(3)))
typedef unsigned short u16;
typedef short bf16x8 __attribute__((ext_vector_type(8)));
typedef float f32x4 __attribute__((ext_vector_type(4)));
typedef unsigned u32x4 __attribute__((ext_vector_type(4)));
typedef unsigned u32x2 __attribute__((ext_vector_type(2)));
#define DI __device__ __forceinline__

constexpr int DM = 1024, NB = 16, SEQ = 2048, DEPTH = 4, CTXL = 256, NIN = 7168;
constexpr int NT = 512;
constexpr int LDS_BYTES = 131072;
#ifndef ONLY
#define ONLY 255
#endif

struct P {
    const float *x, *c, *ctx, *c_ctx, *norm_w, *w_ada, *b_ada, *w_in, *lower, *hn_w, *w_four, *b_four, *w_out, *fnorm_w;
    float* out; unsigned char* ws;
    int ng, bg;
    size_t oWinT, oWoutT, oWu, oWcsT, oWpT, oDx, oDc, oPos, oLbs, oModPart, oMod, oCtx, oH, oV, oZF, oZB, oQ, oG2, oTtx, oTtc, oDbg;
};

typedef __bf16 bf16v2 __attribute__((ext_vector_type(2)));
typedef float f32x2 __attribute__((ext_vector_type(2)));
DI unsigned cvt_pk_bf16(float lo, float hi) { const f32x2 v = {lo, hi}; const bf16v2 b = __builtin_convertvector(v, bf16v2); return __builtin_bit_cast(unsigned, b); }
DI float bf2f(unsigned h) { return __uint_as_float(h << 16); }
DI float bflo(unsigned w) { return __uint_as_float(w << 16); }
DI float bfhi(unsigned w) { return __uint_as_float(w & 0xffff0000u); }
DI unsigned pk_f16(float lo, float hi) { _Float16 a = (_Float16)lo, b = (_Float16)hi; return (unsigned)__builtin_bit_cast(unsigned short, a) | ((unsigned)__builtin_bit_cast(unsigned short, b) << 16); }
DI float h2f(unsigned h) { return (float)__builtin_bit_cast(_Float16, (unsigned short)h); }
DI int tidx() { int t = threadIdx.x; asm volatile("" : "+v"(t)); return t; }
DI float silu(float v) { return v / (1.f + __expf(-v)); }

namespace pg8 {
constexpr int BM = 256, BK = 64, HALF = 128, HTB = HALF * BK * 2, STAGE_BYTES = 8 * HTB, NXCD = 8, WGM = 8;
DI int lds_byte(int r, int c) { const int st = (r >> 4) * 2 + (c >> 5), rr = r & 15, cc = c & 31, ob = rr * 64 + cc * 2; return st * 1024 + (ob ^ (((ob >> 9) & 1) << 5)); }
DI void stage_rc(int b, int& R, int& C) { const int st = b / 1024, sb = b % 1024, swz = sb ^ (((sb >> 9) & 1) << 5); R = (st >> 1) * 16 + swz / 64; C = (st & 1) * 32 + (swz % 64) / 2; }
DI int perm32(int rho) { const int n = rho >> 4, i = rho & 15; return 8 * (i >> 2) + 4 * n + (i & 3); }

struct Unit { int pm, pn, tag, pad; long aoff, boff; };
struct Gemm { const u16* A; const u16* Bt; int lda, ldb, K; };

struct Sched {
    int nM, nN, nB, nw, wi, mode;
    long aTile, bTile, aBatch, bBatch;
    int segmap;
    DI bool next(int i, Unit& u) const {
        const long L = (long)i * nw + wi;
        if (mode == 0) {
            const int nwg = nM * nN; if (L >= nwg) return false;
            int wgid = (int)L; { const int q = nwg / NXCD, r = nwg % NXCD, xcd = wgid % NXCD, off = wgid / NXCD; wgid = (xcd < r ? xcd * (q + 1) : r * (q + 1) + (xcd - r) * q) + off; }
            const int nig = WGM * nN, gid = wgid / nig, fm = gid * WGM, gsz = (nM - fm) < WGM ? (nM - fm) : WGM;
            u.pm = fm + ((wgid % nig) % gsz); u.pn = (wgid % nig) / gsz; u.tag = 0;
        } else {
            const long tot = (long)nB * nM * nN; if (L >= tot) return false;
            const int per = nM * nN; u.tag = (int)(L / per); const int rem = (int)(L % per); u.pm = rem / nN; u.pn = rem % nN;
        }
        u.pad = 0;
        u.aoff = (long)u.tag * aBatch + (long)u.pm * aTile;
        int pnb = u.pn;
        if (segmap) { const int s6 = pnb >> 2; pnb = ((s6 < 5 ? s6 : 6) << 2) + (pnb & 3); }
        u.boff = (long)u.tag * bBatch + (long)pnb * bTile;
        return true;
    }
};

template <class Epi>
DI void gemm_phase(LAS unsigned char* lds, const Gemm g, const Sched& S, const Epi& E) {
    const int tid = tidx(), wid = __builtin_amdgcn_readfirstlane(tid >> 6), lane = tid & 63, wr = wid >> 2, wc = wid & 3, fr = lane & 15, fq = lane >> 4;
    const int K = g.K, nt = K / BK;
    unsigned voffA[2], voffB[2];
#pragma unroll
    for (int i = 0; i < 2; ++i) { int R, C; stage_rc(tid * 16 + i * 8192, R, C); const int Rb = Epi::PERM ? ((R & ~31) + perm32(R & 31)) : R;
        voffA[i] = (unsigned)(R * g.lda + C) * 2u; voffB[i] = (unsigned)(Rb * g.ldb + C) * 2u; }
    const size_t kstep = (size_t)(BK * 2);
    const size_t hstepA = (size_t)HALF * g.lda * 2, hstepB = (size_t)HALF * g.ldb * 2;
    const unsigned ldsw = (unsigned)wid * 1024u;
    const int aoff = lds_byte(wr * 64 + fr, fq * 8), boff = lds_byte(wc * 32 + fr, fq * 8);
#define PG8_SA(b, h) (((b) * 2 + (h)) * HTB)
#define PG8_SB(b, h) ((4 + (b) * 2 + (h)) * HTB)
#define PG8_STAGE(bufoff, gbase, voff) do { _Pragma("unroll") for (int _i = 0; _i < 2; ++_i) \
        __builtin_amdgcn_global_load_lds((const unsigned*)((const char*)(gbase) + (voff)[_i]), (LAS unsigned*)(lds + (bufoff) + ldsw + _i * 8192), 16, 0, 0); } while (0)
#define PG8_LDA(dst, b, h) do { _Pragma("unroll") for (int m = 0; m < 4; ++m) _Pragma("unroll") for (int k = 0; k < 2; ++k) dst[m][k] = *(const LAS bf16x8*)(lds + PG8_SA(b, h) + aoff + m * 2048 + k * 1024); } while (0)
#define PG8_LDB(dst, b, h) do { _Pragma("unroll") for (int n = 0; n < 2; ++n) _Pragma("unroll") for (int k = 0; k < 2; ++k) dst[n][k] = *(const LAS bf16x8*)(lds + PG8_SB(b, h) + boff + n * 2048 + k * 1024); } while (0)
#define PG8_MMA(ai, bj, At, Bt) do { __builtin_amdgcn_s_setprio(1); _Pragma("unroll") for (int m = 0; m < 4; ++m) _Pragma("unroll") for (int n = 0; n < 2; ++n) _Pragma("unroll") for (int k = 0; k < 2; ++k) \
        acc[ai][bj][m][n] = __builtin_amdgcn_mfma_f32_16x16x32_bf16(Bt[n][k], At[m][k], acc[ai][bj][m][n], 0, 0, 0); __builtin_amdgcn_s_setprio(0); } while (0)
#define PG8_WAIT_V(n) asm volatile("s_waitcnt vmcnt(" #n ")" ::: "memory")
#define PG8_WAIT_L(n) asm volatile("s_waitcnt lgkmcnt(" #n ")" ::: "memory")
#define PG8_BAR __builtin_amdgcn_s_barrier()
#define PG8_SCHED __builtin_amdgcn_sched_barrier(0)
    Unit cur, nxt; int ui = 0;
    if (!S.next(0, cur)) return;
    f32x4 acc[2][2][4][2];
#pragma unroll
    for (int a = 0; a < 2; ++a)
#pragma unroll
        for (int b = 0; b < 2; ++b)
#pragma unroll
            for (int m = 0; m < 4; ++m)
#pragma unroll
                for (int n = 0; n < 2; ++n) acc[a][b][m][n] = (f32x4){0.f, 0.f, 0.f, 0.f};
    bf16x8 At[4][2], B0[2][2], B1[2][2];
    const char* cA = (const char*)g.A + cur.aoff; const char* cB = (const char*)g.Bt + cur.boff;
    PG8_STAGE(PG8_SB(0, 0), cB, voffB); PG8_STAGE(PG8_SA(0, 0), cA, voffA); PG8_STAGE(PG8_SB(0, 1), cB + hstepB, voffB); PG8_STAGE(PG8_SA(0, 1), cA + hstepA, voffA);
    if (wr == 1) PG8_BAR;
    PG8_WAIT_V(4); PG8_BAR;
    PG8_STAGE(PG8_SB(1, 0), cB + kstep, voffB); PG8_STAGE(PG8_SA(1, 0), cA + kstep, voffA); PG8_STAGE(PG8_SB(1, 1), cB + hstepB + kstep, voffB);
    PG8_WAIT_V(6); PG8_BAR;
    for (;;) {
        const bool has_next = S.next(ui + 1, nxt);
        const char* nA = has_next ? (const char*)g.A + nxt.aoff : cA; const char* nB = has_next ? (const char*)g.Bt + nxt.boff : cB;
        for (int t = 0; t < nt; t += 2) {
            const bool last = (t == nt - 2);
            const char* a1 = cA + (size_t)(t + 1) * kstep;
            const char* a2 = last ? nA : cA + (size_t)(t + 2) * kstep; const char* b2 = last ? nB : cB + (size_t)(t + 2) * kstep;
            const char* a3 = a2 + kstep; const char* b3 = b2 + kstep;
            PG8_LDB(B0, 0, 0); PG8_SCHED; PG8_LDA(At, 0, 0); PG8_STAGE(PG8_SA(1, 1), a1 + hstepA, voffA);
            PG8_WAIT_L(8); PG8_BAR; PG8_WAIT_L(0); PG8_MMA(0, 0, At, B0); PG8_BAR; PG8_SCHED;
            PG8_LDB(B1, 0, 1); PG8_STAGE(PG8_SB(0, 0), b2, voffB);
            PG8_BAR; PG8_WAIT_L(0); PG8_MMA(0, 1, At, B1); PG8_BAR;
            PG8_LDA(At, 0, 1); PG8_STAGE(PG8_SA(0, 0), a2, voffA);
            PG8_BAR; PG8_WAIT_L(0); PG8_MMA(1, 0, At, B0); PG8_BAR; PG8_SCHED;
            PG8_STAGE(PG8_SB(0, 1), b2 + hstepB, voffB);
            PG8_WAIT_V(6); PG8_BAR; PG8_MMA(1, 1, At, B1); PG8_BAR;
            PG8_LDB(B0, 1, 0); PG8_SCHED; PG8_LDA(At, 1, 0); PG8_STAGE(PG8_SA(0, 1), a2 + hstepA, voffA);
            PG8_WAIT_L(8); PG8_BAR; PG8_WAIT_L(0); PG8_MMA(0, 0, At, B0); PG8_BAR; PG8_SCHED;
            PG8_LDB(B1, 1, 1); PG8_STAGE(PG8_SB(1, 0), b3, voffB);
            PG8_BAR; PG8_WAIT_L(0); PG8_MMA(0, 1, At, B1); PG8_BAR;
            PG8_LDA(At, 1, 1); PG8_STAGE(PG8_SA(1, 0), a3, voffA);
            PG8_BAR; PG8_WAIT_L(0); PG8_MMA(1, 0, At, B0); PG8_BAR; PG8_SCHED;
            PG8_STAGE(PG8_SB(1, 1), b3 + hstepB, voffB);
            PG8_WAIT_V(6); PG8_BAR; PG8_MMA(1, 1, At, B1); PG8_BAR;
        }
        E(acc, cur, wr, wc, fr, fq);
        if (!has_next) break;
#pragma unroll
        for (int a = 0; a < 2; ++a)
#pragma unroll
            for (int b = 0; b < 2; ++b)
#pragma unroll
                for (int m = 0; m < 4; ++m)
#pragma unroll
                    for (int n = 0; n < 2; ++n) acc[a][b][m][n] = (f32x4){0.f, 0.f, 0.f, 0.f};
        cur = nxt; cA = nA; cB = nB; ++ui;
    }
    PG8_WAIT_V(0);
    if (wr == 0) PG8_BAR;
    PG8_BAR;
#undef PG8_SA
#undef PG8_SB
#undef PG8_STAGE
#undef PG8_LDA
#undef PG8_LDB
#undef PG8_MMA
#undef PG8_WAIT_V
#undef PG8_WAIT_L
#undef PG8_BAR
#undef PG8_SCHED
}
}
using pg8::Unit; using pg8::Gemm; using pg8::Sched; using pg8::HALF;
typedef f32x4 Acc[2][2][4][2];

struct EpiIn {
    static constexpr bool PERM = true;
    u16 *V, *ZF, *ZB, *Q, *G2;
    DI void operator()(const Acc& acc, const Unit& u, int wr, int wc, int fr, int fq) const {
        const int s6 = u.pn >> 2, cw = (u.pn & 3) * 256;
        u16* base; int ld = 1024, mode = 0, cofs = cw;
        if (s6 == 0) base = V; else if (s6 == 1) { base = ZF; mode = 1; } else if (s6 == 2) { base = ZB; mode = 1; }
        else if (s6 == 3) { base = Q; mode = 2; } else if (s6 == 4) { base = G2; ld = 2048; mode = 2; } else { base = G2; ld = 2048; mode = 2; cofs = 1024 + cw; }
        const int row0 = u.pm * 256 + wr * 64 + fr, col0 = cofs + wc * 32 + 8 * fq;
#pragma unroll
        for (int ai = 0; ai < 2; ++ai)
#pragma unroll
            for (int m = 0; m < 4; ++m) { u16* rowp = base + (size_t)(row0 + ai * HALF + m * 16) * ld + col0;
#pragma unroll
                for (int bj = 0; bj < 2; ++bj) { f32x4 v0 = acc[ai][bj][m][0], v1 = acc[ai][bj][m][1]; u32x4 w;
                    if (mode == 1) { w.x = pk_f16(v0[0], v0[1]); w.y = pk_f16(v0[2], v0[3]); w.z = pk_f16(v1[0], v1[1]); w.w = pk_f16(v1[2], v1[3]); }
                    else { if (mode == 2) {
#pragma unroll
                            for (int j = 0; j < 4; ++j) { v0[j] = silu(v0[j]); v1[j] = silu(v1[j]); } }
                        w.x = cvt_pk_bf16(v0[0], v0[1]); w.y = cvt_pk_bf16(v0[2], v0[3]); w.z = cvt_pk_bf16(v1[0], v1[1]); w.w = cvt_pk_bf16(v1[2], v1[3]); }
                    *(u32x4*)(rowp + bj * HALF) = w; } }
    }
};
struct EpiBf {
    static constexpr bool PERM = true;
    u16* O; int ld; long batchStride;
    DI void operator()(const Acc& acc, const Unit& u, int wr, int wc, int fr, int fq) const {
        u16* base = O + (size_t)u.tag * batchStride;
        const int row0 = u.pm * 256 + wr * 64 + fr, col0 = u.pn * 256 + wc * 32 + 8 * fq;
#pragma unroll
        for (int ai = 0; ai < 2; ++ai)
#pragma unroll
            for (int m = 0; m < 4; ++m) { u16* rowp = base + (size_t)(row0 + ai * HALF + m * 16) * ld + col0;
#pragma unroll
                for (int bj = 0; bj < 2; ++bj) { const f32x4 v0 = acc[ai][bj][m][0], v1 = acc[ai][bj][m][1]; u32x4 w;
                    w.x = cvt_pk_bf16(v0[0], v0[1]); w.y = cvt_pk_bf16(v0[2], v0[3]); w.z = cvt_pk_bf16(v1[0], v1[1]); w.w = cvt_pk_bf16(v1[2], v1[3]);
                    *(u32x4*)(rowp + bj * HALF) = w; } }
    }
};
struct EpiTt {
    static constexpr bool PERM = true;
    u16 *Ttx, *Ttc; int bg;
    DI void operator()(const Acc& acc, const Unit& u, int wr, int wc, int fr, int fq) const {
        const int g = u.pm >> 1, half = u.pm & 1;
        u16* base; int Lp, bl;
        if (u.pn < bg * 8) { bl = u.pn >> 3; Lp = 2048; base = Ttx + (size_t)(bl * 4 + g) * 256 * 4096 + half * 2048 + (u.pn & 7) * 256; }
        else { bl = u.pn - bg * 8; Lp = 256; base = Ttc + (size_t)(bl * 4 + g) * 256 * 512 + half * 256; }
        const int n0 = wr * 64 + fr, col0 = wc * 32 + 8 * fq;
#pragma unroll
        for (int ai = 0; ai < 2; ++ai)
#pragma unroll
            for (int m = 0; m < 4; ++m) { u16* rowp = base + (size_t)(n0 + ai * HALF + m * 16) * (2 * Lp) + col0;
#pragma unroll
                for (int bj = 0; bj < 2; ++bj) { const f32x4 v0 = acc[ai][bj][m][0], v1 = acc[ai][bj][m][1]; u32x4 w;
                    w.x = cvt_pk_bf16(v0[0], v0[1]); w.y = cvt_pk_bf16(v0[2], v0[3]); w.z = cvt_pk_bf16(v1[0], v1[1]); w.w = cvt_pk_bf16(v1[2], v1[3]);
                    *(u32x4*)(rowp + bj * HALF) = w; } }
    }
};
struct EpiF3 {
    static constexpr bool PERM = true;
    u16* G2; const float* bias; float scale; int rowbase, Lp;
    DI void operator()(const Acc& acc, const Unit& u, int wr, int wc, int fr, int fq) const {
        const int bl = u.tag >> 2, g = u.tag & 3;
        const int row0 = rowbase + bl * Lp + u.pm * 256 + wr * 64 + fr, col0 = wc * 32 + 8 * fq;
        const float* bp = bias + g * 256 + col0;
        f32x4 bv[2][2];
#pragma unroll
        for (int bj = 0; bj < 2; ++bj) { bv[bj][0] = *(const f32x4*)(bp + bj * HALF); bv[bj][1] = *(const f32x4*)(bp + bj * HALF + 4); }
#pragma unroll
        for (int ai = 0; ai < 2; ++ai)
#pragma unroll
            for (int m = 0; m < 4; ++m) { u16* rowp = G2 + (size_t)(row0 + ai * HALF + m * 16) * 2048 + 1024 + g * 256 + col0;
#pragma unroll
                for (int bj = 0; bj < 2; ++bj) { const f32x4 v0 = acc[ai][bj][m][0] * scale + bv[bj][0], v1 = acc[ai][bj][m][1] * scale + bv[bj][1];
                    const u32x4 gt = *(const u32x4*)(rowp + bj * HALF); u32x4 w;
                    w.x = cvt_pk_bf16(v0[0] * bflo(gt.x), v0[1] * bfhi(gt.x)); w.y = cvt_pk_bf16(v0[2] * bflo(gt.y), v0[3] * bfhi(gt.y));
                    w.z = cvt_pk_bf16(v1[0] * bflo(gt.z), v1[1] * bfhi(gt.z)); w.w = cvt_pk_bf16(v1[2] * bflo(gt.w), v1[3] * bfhi(gt.w));
                    *(u32x4*)(rowp + bj * HALF) = w; } }
    }
};
struct EpiOut {
    static constexpr bool PERM = false;
    float *xg, *cg_; const float* modl; int bg, grp;
    DI void operator()(const Acc& acc, const Unit& u, int wr, int wc, int fr, int fq) const {
        const int r0 = u.pm * 256; float* dst; const float* gate;
        if (r0 < bg * 2048) { dst = xg + (size_t)r0 * 1024; gate = modl + (size_t)(grp * bg + (r0 >> 11)) * 3072 + 2048; }
        else { dst = cg_ + (size_t)(r0 - bg * 2048) * 1024; gate = modl + (size_t)16 * 3072 + 2048; }
        const int row0 = wr * 64 + fr, col0 = u.pn * 256 + wc * 32 + 4 * fq;
        f32x4 gv[2][2];
#pragma unroll
        for (int bj = 0; bj < 2; ++bj)
#pragma unroll
            for (int n = 0; n < 2; ++n) gv[bj][n] = *(const f32x4*)(gate + col0 + bj * HALF + n * 16);
#pragma unroll
        for (int ai = 0; ai < 2; ++ai)
#pragma unroll
            for (int m = 0; m < 4; ++m) { float* rowp = dst + (size_t)(row0 + ai * HALF + m * 16) * 1024 + col0;
#pragma unroll
                for (int bj = 0; bj < 2; ++bj)
#pragma unroll
                    for (int n = 0; n < 2; ++n) { f32x4* pp = (f32x4*)(rowp + bj * HALF + n * 16); *pp = *pp + gv[bj][n] * acc[ai][bj][m][n]; } }
    }
};

DI void transpose_cvt(const float* src, u16* dst, int nl, int R, int C, LAS float* tile, int c, int G) {
    const int tid = tidx(), ntr = R / 64, ntc = C / 64, per = ntr * ntc;
    for (int t = c; t < nl * per; t += G) {
        const int l = t / per, rem = t % per, tr = rem / ntc, tc = rem % ntc;
        const float* s = src + ((size_t)l * R + tr * 64) * C + tc * 64;
        u16* d = dst + ((size_t)l * C + tc * 64) * R + tr * 64;
        __syncthreads();
        { const int row = tid >> 3, c8 = (tid & 7) * 8; const f32x4 a = *(const f32x4*)(s + (size_t)row * C + c8), b = *(const f32x4*)(s + (size_t)row * C + c8 + 4);
#pragma unroll
          for (int e = 0; e < 4; ++e) { tile[row * 65 + c8 + e] = a[e]; tile[row * 65 + c8 + 4 + e] = b[e]; } }
        __syncthreads();
        { const int oc = tid >> 3, rg = (tid & 7) * 8; float v[8];
#pragma unroll
          for (int e = 0; e < 8; ++e) v[e] = tile[(rg + e) * 65 + oc];
          u32x4 w; w.x = cvt_pk_bf16(v[0], v[1]); w.y = cvt_pk_bf16(v[2], v[3]); w.z = cvt_pk_bf16(v[4], v[5]); w.w = cvt_pk_bf16(v[6], v[7]);
          *(u32x4*)(d + (size_t)oc * R + rg) = w; }
    }
}

__device__ __forceinline__ void phase_p0a(const P& p, LAS unsigned char* lds) {
    const int tid = tidx(), c = blockIdx.x, G = gridDim.x;
    const size_t gtid = (size_t)c * NT + tid, gsz = (size_t)G * NT;
    for (int it = c; it < 192; it += G) {
        const int l = it / 48, kp = (it / 6) % 8, nc = it % 6;
        LAS float* sc = (LAS float*)lds;
        __syncthreads();
        for (int i = tid; i < 17 * 128; i += NT) { const int r = i >> 7, k = i & 127; const float v = r < 16 ? p.c[r * 1024 + kp * 128 + k] : p.c_ctx[kp * 128 + k]; sc[i] = silu(v); }
        __syncthreads();
        const int n = nc * 512 + tid;
        float acc[17];
#pragma unroll
        for (int r = 0; r < 17; ++r) acc[r] = 0.f;
        const float* w = p.w_ada + ((size_t)l * 1024 + kp * 128) * 3072 + n;
        for (int k = 0; k < 128; ++k) { const float wv = w[(size_t)k * 3072];
#pragma unroll
            for (int r = 0; r < 17; ++r) acc[r] += sc[r * 128 + k] * wv; }
        float* mp = (float*)(p.ws + p.oModPart) + (((size_t)l * 8 + kp) * 17) * 3072 + n;
#pragma unroll
        for (int r = 0; r < 17; ++r) mp[(size_t)r * 3072] = acc[r];
    }
    __syncthreads();
    transpose_cvt(p.w_in, (u16*)(p.ws + p.oWinT), DEPTH, 1024, NIN, (LAS float*)lds, c, G);
    transpose_cvt(p.w_out, (u16*)(p.ws + p.oWoutT), DEPTH, 2048, 1024, (LAS float*)lds, c, G);
    __syncthreads();
    { u16* Wu = (u16*)(p.ws + p.oWu);
      for (size_t i = gtid; i < (size_t)DEPTH * 1024 * 128; i += gsz) { const size_t lk = i >> 7; const int c8 = (int)(i & 127) * 8; const float* s = p.w_in + lk * NIN + 5120 + c8;
          const f32x4 a = *(const f32x4*)s, b = *(const f32x4*)(s + 4); u32x4 w; w.x = cvt_pk_bf16(a[0], a[1]); w.y = cvt_pk_bf16(a[2], a[3]); w.z = cvt_pk_bf16(b[0], b[1]); w.w = cvt_pk_bf16(b[2], b[3]);
          *(u32x4*)(Wu + lk * 1024 + c8) = w; } }
    { LAS float* ct = (LAS float*)lds; for (int i = tid; i < 256; i += NT) ct[i] = cospif((float)i / 128.f);
      __syncthreads();
      u16* Wc = (u16*)(p.ws + p.oWcsT);
      for (size_t o = gtid; o < (size_t)16 * 512 * 256; o += gsz) { const int cin = (int)(o & 255), j = (int)(o >> 8) & 511, lg = (int)(o >> 17);
          const float* W = p.w_four + (size_t)lg * 65536 + (j & 255); const int ph = (j < 256) ? 0 : 192; float s = 0.f;
          for (int cp = 0; cp < 256; ++cp) s += ct[(cin * cp + ph) & 255] * W[(size_t)cp * 256];
          Wc[o] = (u16)(cvt_pk_bf16(s, 0.f) & 0xffffu); }
      __syncthreads(); }
    { u16* Dx = (u16*)(p.ws + p.oDx);
      for (size_t o = gtid; o < (size_t)2048 * 4096 / 8; o += gsz) { const int lp = (int)(o >> 9), k8 = (int)(o & 511) * 8; float v[8];
#pragma unroll
          for (int e = 0; e < 8; ++e) { const int kk = k8 + e; const int idx = (lp * (kk & 2047)) & 2047; const float a = (float)idx / 1024.f; v[e] = kk < 2048 ? cospif(a) : -sinpif(a); }
          u32x4 w; w.x = cvt_pk_bf16(v[0], v[1]); w.y = cvt_pk_bf16(v[2], v[3]); w.z = cvt_pk_bf16(v[4], v[5]); w.w = cvt_pk_bf16(v[6], v[7]);
          *(u32x4*)(Dx + o * 8) = w; }
      u16* Dc = (u16*)(p.ws + p.oDc);
      for (size_t o = gtid; o < (size_t)256 * 512 / 8; o += gsz) { const int lp = (int)(o >> 6), k8 = (int)(o & 63) * 8; float v[8];
#pragma unroll
          for (int e = 0; e < 8; ++e) { const int kk = k8 + e; const int idx = (lp * (kk & 255)) & 255; const float a = (float)idx / 128.f; v[e] = kk < 256 ? cospif(a) : -sinpif(a); }
          u32x4 w; w.x = cvt_pk_bf16(v[0], v[1]); w.y = cvt_pk_bf16(v[2], v[3]); w.z = cvt_pk_bf16(v[4], v[5]); w.w = cvt_pk_bf16(v[6], v[7]);
          *(u32x4*)(Dc + o * 8) = w; } }
    { float* pos = (float*)(p.ws + p.oPos);
      for (size_t o = gtid; o < (size_t)2048 * 1024; o += gsz) { const int t = (int)(o >> 10), d = (int)(o & 1023), i = d & 255;
          const float omega = exp2f(-(float)i * (13.287712379549449f / 256.f)); const float pp = (float)(d < 512 ? (t >> 6) : (t & 63)); const float ang = pp * omega;
          pos[o] = ((d >> 8) & 1) ? cosf(ang) : sinf(ang); } }
    { float* lbs = (float*)(p.ws + p.oLbs);
      for (size_t o = gtid; o < 2048; o += gsz) { const int dir = (int)(o >> 10), ch = (int)(o & 1023); float v[4], mx = -1e30f;
#pragma unroll
          for (int l = 0; l < 4; ++l) { v[l] = p.lower[(dir * 4 + l) * 1024 + ch]; mx = fmaxf(mx, v[l]); }
          float s = 0.f;
#pragma unroll
          for (int l = 0; l < 4; ++l) { v[l] = expf(v[l] - mx); s += v[l]; }
          float cum = 0.f; lbs[(dir * 4 + 0) * 1024 + ch] = 0.f;
#pragma unroll
          for (int l = 1; l < 4; ++l) { cum += v[l] / s; lbs[(dir * 4 + l) * 1024 + ch] = cum; } } }
}

__device__ __forceinline__ void phase_p0b(const P& p, LAS unsigned char* lds) {
    const int tid = tidx(), c = blockIdx.x, G = gridDim.x;
    const size_t gtid = (size_t)c * NT + tid, gsz = (size_t)G * NT;
    {
        for (int l = 0; l < DEPTH; ++l) {
            Gemm g; g.A = (const u16*)(p.ws + p.oWcsT) + (size_t)l * 4 * 512 * 256; g.Bt = (const u16*)(p.ws + p.oWu) + (size_t)l * 1024 * 1024; g.lda = 256; g.ldb = 1024; g.K = 256;
            Sched S; S.nM = 2; S.nN = 4; S.nB = 4; S.nw = G; S.wi = (c + l * 32) % G; S.mode = 1; S.aTile = 256L * 256 * 2; S.bTile = 256L * 1024 * 2; S.aBatch = 512L * 256 * 2; S.bBatch = 256L * 2; S.segmap = 0;
            EpiBf E; E.O = (u16*)(p.ws + p.oWpT) + (size_t)l * 2048 * 1024; E.ld = 1024; E.batchStride = 512L * 1024;
            pg8::gemm_phase<EpiBf>(lds, g, S, E);
        }
    }
    { float* mod = (float*)(p.ws + p.oMod); const float* mp = (const float*)(p.ws + p.oModPart);
      for (size_t o = gtid; o < (size_t)DEPTH * 17 * 3072; o += gsz) { const int n = (int)(o % 3072), r = (int)(o / 3072) % 17, l = (int)(o / (3072 * 17)); float s = p.b_ada[l * 3072 + n];
#pragma unroll
          for (int kp = 0; kp < 8; ++kp) s += mp[(((size_t)l * 8 + kp) * 17 + r) * 3072 + n];
          mod[o] = s; } }
    { const float* pos = (const float*)(p.ws + p.oPos);
      for (size_t o = gtid; o < (size_t)NB * SEQ * DM / 4; o += gsz) { const size_t e = o * 4; const size_t pe = e & ((size_t)SEQ * DM - 1);
          *(f32x4*)(p.out + e) = *(const f32x4*)(p.x + e) + *(const f32x4*)(pos + pe); }
      float* cc = (float*)(p.ws + p.oCtx);
      for (size_t o = gtid; o < (size_t)NB * CTXL * DM / 4; o += gsz) *(f32x4*)(cc + o * 4) = *(const f32x4*)(p.ctx + o * 4); }
}

__device__ __forceinline__ void phase_norm(const P& p, int l, int grp) {
    const int tid = tidx(), lane = tid & 63, w = tid >> 6, c = blockIdx.x, G = gridDim.x, bg = p.bg;
    const int Mg = bg * 2304;
    const float* modl = (const float*)(p.ws + p.oMod) + (size_t)l * 17 * 3072;
    const float* nw = p.norm_w + l * 1024;
    u16* H = (u16*)(p.ws + p.oH);
    for (int row = c * 8 + w; row < Mg; row += G * 8) {
        const float* src; int mr;
        if (row < bg * 2048) { src = p.out + ((size_t)grp * bg * 2048 + row) * 1024; mr = grp * bg + (row >> 11); }
        else { src = (const float*)(p.ws + p.oCtx) + ((size_t)grp * bg * 256 + (row - bg * 2048)) * 1024; mr = 16; }
        const float* md = modl + (size_t)mr * 3072;
        f32x4 v[4]; float ss = 0.f;
#pragma unroll
        for (int i = 0; i < 4; ++i) { v[i] = *(const f32x4*)(src + i * 256 + lane * 4); ss += v[i][0] * v[i][0] + v[i][1] * v[i][1] + v[i][2] * v[i][2] + v[i][3] * v[i][3]; }
#pragma unroll
        for (int o = 32; o >= 1; o >>= 1) ss += __shfl_xor(ss, o);
        const float rs = rsqrtf(ss * (1.f / 1024.f) + 1e-6f);
#pragma unroll
        for (int i = 0; i < 4; ++i) { const int col = i * 256 + lane * 4; const f32x4 wv = *(const f32x4*)(nw + col), sh = *(const f32x4*)(md + col), scl = *(const f32x4*)(md + 1024 + col);
            const f32x4 y = v[i] * rs * wv * (scl + 1.f) + sh; u32x2 o; o.x = cvt_pk_bf16(y[0], y[1]); o.y = cvt_pk_bf16(y[2], y[3]);
            *(u32x2*)(H + (size_t)row * 1024 + col) = o; }
    }
}

__device__ __forceinline__ void phase_gemm_in(const P& p, int l, LAS unsigned char* lds) {
    const int c = blockIdx.x, G = gridDim.x, bg = p.bg; const int nMt = bg * 9;
    { Gemm g; g.A = (const u16*)(p.ws + p.oH); g.Bt = (const u16*)(p.ws + p.oWinT) + (size_t)l * NIN * 1024; g.lda = 1024; g.ldb = 1024; g.K = 1024;
      Sched S; S.nM = nMt; S.nN = 24; S.nB = 1; S.nw = G; S.wi = c; S.mode = 0; S.aTile = 256L * 1024 * 2; S.bTile = 256L * 1024 * 2; S.aBatch = 0; S.bBatch = 0; S.segmap = 1;
      EpiIn E; E.V = (u16*)(p.ws + p.oV); E.ZF = (u16*)(p.ws + p.oZF); E.ZB = (u16*)(p.ws + p.oZB); E.Q = (u16*)(p.ws + p.oQ); E.G2 = (u16*)(p.ws + p.oG2);
      pg8::gemm_phase<EpiIn>(lds, g, S, E); }
    { Gemm g; g.A = (const u16*)(p.ws + p.oWpT) + (size_t)l * 2048 * 1024; g.Bt = (const u16*)(p.ws + p.oH); g.lda = 1024; g.ldb = 1024; g.K = 1024;
      Sched S; S.nM = 8; S.nN = nMt; S.nB = 1; S.nw = G; S.wi = (c + 192) % G; S.mode = 0; S.aTile = 256L * 1024 * 2; S.bTile = 256L * 1024 * 2; S.aBatch = 0; S.bBatch = 0; S.segmap = 0;
      EpiTt E; E.Ttx = (u16*)(p.ws + p.oTtx); E.Ttc = (u16*)(p.ws + p.oTtc); E.bg = bg;
      pg8::gemm_phase<EpiTt>(lds, g, S, E); }
}

__device__ __forceinline__ void scan_chain(const P& p, int l, int ci, LAS unsigned char* lds) {
    const int tid = tidx(), lane = tid & 63, w = __builtin_amdgcn_readfirstlane(tid >> 6), r = lane & 15, q = lane >> 4;
    const int bg = p.bg;
    const int bl = ci >> 4, dir = (ci >> 3) & 1, h = ci & 7;
    const u16* Vg = (const u16*)(p.ws + p.oV) + h * 128;
    const u16* Qg = (const u16*)(p.ws + p.oQ) + h * 128;
    u16* Zg = (u16*)(p.ws + (dir ? p.oZB : p.oZF)) + h * 128;
    const float* lb = (const float*)(p.ws + p.oLbs) + (dir * 4 + l) * 1024 + h * 128;
    LAS float* Gs = (LAS float*)lds;
    LAS float* Ks = Gs + 4096;
    LAS unsigned char* Qs = lds + 32768;
    LAS unsigned char* Vs = Qs + 2 * 8704;
    LAS unsigned char* Kn = Vs + 2 * 8704;
    LAS unsigned char* Kt = Kn + 8704;
    LAS float* Tot = (LAS float*)(Kt + 10240);
    LAS float* Eend = Tot + 512;
    LAS float* Er = Eend + 128;
    LAS float* Eer = Er + 128;
    const int tok = tid >> 4, cg8 = (tid & 15) * 8;
    float oml[8];
#pragma unroll
    for (int e = 0; e < 8; ++e) oml[e] = 1.f - lb[cg8 + e];
    f32x4 S[8];
#pragma unroll
    for (int i = 0; i < 8; ++i) S[i] = (f32x4){0.f, 0.f, 0.f, 0.f};
    auto rowof = [&](int cc, int t) -> int { const int part = cc >= 8, cidx = part ? cc - 8 : cc, pos = cidx * 32 + t, Lp = part ? 2048 : 256, base = part ? bl * 2048 : bg * 2048 + bl * 256;
        return base + (dir ? Lp - 1 - pos : pos); };
    u32x4 zc, qc, vc, zn, qn, vn;
    { const size_t ro = (size_t)rowof(0, tok) * 1024 + cg8; zc = *(const u32x4*)(Zg + ro); qc = *(const u32x4*)(Qg + ro); vc = *(const u32x4*)(Vg + ro); }
    zn = zc; qn = qc; vn = vc;
    __syncthreads();
    for (int cc = 0; cc < 72; ++cc) {
        const int par = cc & 1;
        if (cc + 1 < 72) { const size_t ro = (size_t)rowof(cc + 1, tok) * 1024 + cg8; zn = *(const u32x4*)(Zg + ro); qn = *(const u32x4*)(Qg + ro); vn = *(const u32x4*)(Vg + ro); }
        { float gv[8], kv[8];
#pragma unroll
          for (int e = 0; e < 8; ++e) { const unsigned hw = (zc[e >> 1] >> (16 * (e & 1))) & 0xffffu; const float z = h2f(hw); const float k = oml[e] / (1.f + __expf(z));
              kv[e] = k; gv[e] = __logf(fmaxf(1.f - k, 1e-6f)); }
          *(LAS f32x4*)(Gs + tok * 128 + cg8) = (f32x4){gv[0], gv[1], gv[2], gv[3]}; *(LAS f32x4*)(Gs + tok * 128 + cg8 + 4) = (f32x4){gv[4], gv[5], gv[6], gv[7]};
          *(LAS f32x4*)(Ks + tok * 128 + cg8) = (f32x4){kv[0], kv[1], kv[2], kv[3]}; *(LAS f32x4*)(Ks + tok * 128 + cg8 + 4) = (f32x4){kv[4], kv[5], kv[6], kv[7]};
          *(LAS u32x4*)(Qs + par * 8704 + tok * 272 + cg8 * 2) = qc; *(LAS u32x4*)(Vs + par * 8704 + tok * 272 + cg8 * 2) = vc; }
        __syncthreads();
        { const int d = tid & 127, tg = tid >> 7; float c8[8], k8[8];
#pragma unroll
          for (int i = 0; i < 8; ++i) { c8[i] = Gs[(8 * tg + i) * 128 + d]; k8[i] = Ks[(8 * tg + i) * 128 + d]; }
#pragma unroll
          for (int i = 1; i < 8; ++i) c8[i] += c8[i - 1];
          Tot[tg * 128 + d] = c8[7];
          __syncthreads();
          const float t0 = Tot[d], t1 = Tot[128 + d], t2s = Tot[256 + d], t3 = Tot[384 + d];
          const float rr = t0 + t1, bend = rr + t2s + t3;
          const float off = (tg == 0 ? 0.f : (tg == 1 ? t0 : (tg == 2 ? rr : rr + t2s))) - rr;
          if (tg == 3) Eend[d] = __expf(bend); else if (tg == 2) Er[d] = __expf(rr); else if (tg == 1) Eer[d] = __expf(bend - rr);
          LAS unsigned char* Qp = Qs + par * 8704; unsigned kt[4];
#pragma unroll
          for (int i = 0; i < 8; i += 2) {
              const float b0 = off + c8[i], b1 = off + c8[i + 1];
              LAS u16* q0 = (LAS u16*)(Qp + (8 * tg + i) * 272 + d * 2); LAS u16* q1 = (LAS u16*)(Qp + (8 * tg + i + 1) * 272 + d * 2);
              const float qa = bf2f(*q0) * __expf(fminf(b0, 75.f)), qb = bf2f(*q1) * __expf(fminf(b1, 75.f));
              const unsigned qq = cvt_pk_bf16(qa, qb); *q0 = (u16)(qq & 0xffffu); *q1 = (u16)(qq >> 16);
              const unsigned kk = cvt_pk_bf16(k8[i] * __expf(fminf(-b0, 75.f)), k8[i + 1] * __expf(fminf(-b1, 75.f))); kt[i >> 1] = kk;
              *(LAS u16*)(Kn + (8 * tg + i) * 272 + d * 2) = (u16)(kk & 0xffffu); *(LAS u16*)(Kn + (8 * tg + i + 1) * 272 + d * 2) = (u16)(kk >> 16); }
          *(LAS u32x4*)(Kt + d * 80 + tg * 16) = (u32x4){kt[0], kt[1], kt[2], kt[3]}; }
        __syncthreads();
        { const LAS unsigned char* Qp = Qs + par * 8704; const LAS unsigned char* Vp = Vs + par * 8704;
          f32x4 P00 = {0.f, 0.f, 0.f, 0.f}, P01 = P00, P11 = P00;
#pragma unroll
          for (int ks = 0; ks < 4; ++ks) {
              const bf16x8 a0 = *(const LAS bf16x8*)(Kn + r * 272 + ks * 64 + q * 16), a1 = *(const LAS bf16x8*)(Kn + (16 + r) * 272 + ks * 64 + q * 16);
              const bf16x8 b0 = *(const LAS bf16x8*)(Qp + r * 272 + ks * 64 + q * 16), b1 = *(const LAS bf16x8*)(Qp + (16 + r) * 272 + ks * 64 + q * 16);
              P00 = __builtin_amdgcn_mfma_f32_16x16x32_bf16(a0, b0, P00, 0, 0, 0);
              P01 = __builtin_amdgcn_mfma_f32_16x16x32_bf16(a0, b1, P01, 0, 0, 0);
              P11 = __builtin_amdgcn_mfma_f32_16x16x32_bf16(a1, b1, P11, 0, 0, 0); }
#pragma unroll
          for (int j = 0; j < 4; ++j) { if (4 * q + j > r) { P00[j] = 0.f; P11[j] = 0.f; } }
          u32x4 bp0, bp1;
          bp0.x = cvt_pk_bf16(P00[0], P00[1]); bp0.y = cvt_pk_bf16(P00[2], P00[3]); bp0.z = 0u; bp0.w = 0u;
          bp1.x = cvt_pk_bf16(P01[0], P01[1]); bp1.y = cvt_pk_bf16(P01[2], P01[3]); bp1.z = cvt_pk_bf16(P11[0], P11[1]); bp1.w = cvt_pk_bf16(P11[2], P11[3]);
          f32x4 O0 = {0.f, 0.f, 0.f, 0.f}, O1 = O0;
#pragma unroll
          for (int ks = 0; ks < 4; ++ks) {
              const f32x4 e0 = *(const LAS f32x4*)(Er + 32 * ks + 4 * q), e1 = *(const LAS f32x4*)(Er + 32 * ks + 16 + 4 * q);
              const f32x4 s0 = S[2 * ks] * e0, s1 = S[2 * ks + 1] * e1;
              u32x4 a; a.x = cvt_pk_bf16(s0[0], s0[1]); a.y = cvt_pk_bf16(s0[2], s0[3]); a.z = cvt_pk_bf16(s1[0], s1[1]); a.w = cvt_pk_bf16(s1[2], s1[3]);
              const u32x2 l0 = *(const LAS u32x2*)(Qp + r * 272 + (32 * ks + 4 * q) * 2), h0 = *(const LAS u32x2*)(Qp + r * 272 + (32 * ks + 16 + 4 * q) * 2);
              const u32x2 l1 = *(const LAS u32x2*)(Qp + (16 + r) * 272 + (32 * ks + 4 * q) * 2), h1 = *(const LAS u32x2*)(Qp + (16 + r) * 272 + (32 * ks + 16 + 4 * q) * 2);
              const u32x4 b0 = {l0.x, l0.y, h0.x, h0.y}, b1 = {l1.x, l1.y, h1.x, h1.y};
              O0 = __builtin_amdgcn_mfma_f32_16x16x32_bf16(__builtin_bit_cast(bf16x8, a), __builtin_bit_cast(bf16x8, b0), O0, 0, 0, 0);
              O1 = __builtin_amdgcn_mfma_f32_16x16x32_bf16(__builtin_bit_cast(bf16x8, a), __builtin_bit_cast(bf16x8, b1), O1, 0, 0, 0); }
          { bf16x8 av;
#pragma unroll
            for (int j8 = 0; j8 < 8; ++j8) { const int s = 16 * (j8 >> 2) + 4 * q + (j8 & 3); av[j8] = (short)*(const LAS u16*)(Vp + s * 272 + (16 * w + r) * 2); }
            O0 = __builtin_amdgcn_mfma_f32_16x16x32_bf16(av, __builtin_bit_cast(bf16x8, bp0), O0, 0, 0, 0);
            O1 = __builtin_amdgcn_mfma_f32_16x16x32_bf16(av, __builtin_bit_cast(bf16x8, bp1), O1, 0, 0, 0); }
          { u32x2 o; o.x = cvt_pk_bf16(O0[0], O0[1]); o.y = cvt_pk_bf16(O0[2], O0[3]); *(u32x2*)(Zg + (size_t)rowof(cc, r) * 1024 + 16 * w + 4 * q) = o;
            o.x = cvt_pk_bf16(O1[0], O1[1]); o.y = cvt_pk_bf16(O1[2], O1[3]); *(u32x2*)(Zg + (size_t)rowof(cc, 16 + r) * 1024 + 16 * w + 4 * q) = o; }
          { bf16x8 bv;
#pragma unroll
            for (int j8 = 0; j8 < 8; ++j8) bv[j8] = (short)*(const LAS u16*)(Vp + (8 * q + j8) * 272 + (16 * w + r) * 2);
#pragma unroll
            for (int i = 0; i < 8; ++i) { const bf16x8 a = *(const LAS bf16x8*)(Kt + (16 * i + r) * 80 + q * 16);
                const f32x4 U = __builtin_amdgcn_mfma_f32_16x16x32_bf16(a, bv, (f32x4){0.f, 0.f, 0.f, 0.f}, 0, 0, 0);
                const f32x4 e = *(const LAS f32x4*)(Eend + 16 * i + 4 * q), f = *(const LAS f32x4*)(Eer + 16 * i + 4 * q); S[i] = S[i] * e + U * f; } } }
        zc = zn; qc = qn; vc = vn;
    }
    __syncthreads();
}

__device__ __forceinline__ void phase_scan_f3(const P& p, int l, LAS unsigned char* lds) {
    const int c = blockIdx.x, G = gridDim.x, bg = p.bg; const int nch = bg * 16;
#if (ONLY & 16)
    for (int ci = c; ci < nch; ci += G) scan_chain(p, l, ci, lds);
#endif
#if (ONLY & 64)
    int nw, wi;
    if (G > nch) { nw = G - nch; wi = c - nch; if (c < nch) return; } else { nw = G; wi = c; }
    { Gemm g; g.A = (const u16*)(p.ws + p.oDx); g.Bt = (const u16*)(p.ws + p.oTtx); g.lda = 4096; g.ldb = 4096; g.K = 4096;
      Sched S; S.nM = 8; S.nN = 1; S.nB = bg * 4; S.nw = nw; S.wi = wi; S.mode = 1; S.aTile = 256L * 4096 * 2; S.bTile = 0; S.aBatch = 0; S.bBatch = 256L * 4096 * 2; S.segmap = 0;
      EpiF3 E; E.G2 = (u16*)(p.ws + p.oG2); E.bias = p.b_four + l * 1024; E.scale = 1.f / sqrtf(2048.f * 256.f); E.rowbase = 0; E.Lp = 2048;
      pg8::gemm_phase<EpiF3>(lds, g, S, E); }
    { Gemm g; g.A = (const u16*)(p.ws + p.oDc); g.Bt = (const u16*)(p.ws + p.oTtc); g.lda = 512; g.ldb = 512; g.K = 512;
      Sched S; S.nM = 1; S.nN = 1; S.nB = bg * 4; S.nw = nw; S.wi = (wi + nw / 2) % nw; S.mode = 1; S.aTile = 0; S.bTile = 0; S.aBatch = 0; S.bBatch = 256L * 512 * 2; S.segmap = 0;
      EpiF3 E; E.G2 = (u16*)(p.ws + p.oG2); E.bias = p.b_four + l * 1024; E.scale = 1.f / sqrtf(256.f * 256.f); E.rowbase = bg * 2048; E.Lp = 256;
      pg8::gemm_phase<EpiF3>(lds, g, S, E); }
#endif
}

__device__ __forceinline__ void phase_combine(const P& p, int l) {
    const int tid = tidx(), c = blockIdx.x, G = gridDim.x, bg = p.bg; const int Mg = bg * 2304;
    const u16* OF = (const u16*)(p.ws + p.oZF); const u16* OB = (const u16*)(p.ws + p.oZB); u16* G2 = (u16*)(p.ws + p.oG2);
    const int ch = (tid & 127) * 8; const float* hw = p.hn_w + l * 1024 + ch;
    float hv[8];
#pragma unroll
    for (int e = 0; e < 8; ++e) hv[e] = hw[e];
    for (int row = c * 4 + (tid >> 7); row < Mg; row += G * 4) {
        const u32x4 a = *(const u32x4*)(OF + (size_t)row * 1024 + ch), b = *(const u32x4*)(OB + (size_t)row * 1024 + ch), gt = *(const u32x4*)(G2 + (size_t)row * 2048 + ch);
        float o[8], gg[8]; float ss = 0.f;
#pragma unroll
        for (int e = 0; e < 4; ++e) { o[2 * e] = bflo(a[e]) + bflo(b[e]); o[2 * e + 1] = bfhi(a[e]) + bfhi(b[e]); gg[2 * e] = bflo(gt[e]); gg[2 * e + 1] = bfhi(gt[e]); }
#pragma unroll
        for (int e = 0; e < 8; ++e) ss += o[e] * o[e];
#pragma unroll
        for (int m = 8; m >= 1; m >>= 1) ss += __shfl_xor(ss, m);
        const float rs = rsqrtf(ss * (1.f / 128.f) + 1e-6f);
        u32x4 wv;
#pragma unroll
        for (int e = 0; e < 4; ++e) wv[e] = cvt_pk_bf16(o[2 * e] * rs * hv[2 * e] * gg[2 * e], o[2 * e + 1] * rs * hv[2 * e + 1] * gg[2 * e + 1]);
        *(u32x4*)(G2 + (size_t)row * 2048 + ch) = wv;
    }
}

__device__ __forceinline__ void phase_gemm_out(const P& p, int l, int grp, LAS unsigned char* lds) {
    const int c = blockIdx.x, G = gridDim.x, bg = p.bg;
    Gemm g; g.A = (const u16*)(p.ws + p.oG2); g.Bt = (const u16*)(p.ws + p.oWoutT) + (size_t)l * 1024 * 2048; g.lda = 2048; g.ldb = 2048; g.K = 2048;
    Sched S; S.nM = bg * 9; S.nN = 4; S.nB = 1; S.nw = G; S.wi = c; S.mode = 0; S.aTile = 256L * 2048 * 2; S.bTile = 256L * 2048 * 2; S.aBatch = 0; S.bBatch = 0; S.segmap = 0;
    EpiOut E; E.xg = p.out + (size_t)grp * bg * 2048 * 1024; E.cg_ = (float*)(p.ws + p.oCtx) + (size_t)grp * bg * 256 * 1024; E.modl = (const float*)(p.ws + p.oMod) + (size_t)l * 17 * 3072; E.bg = bg; E.grp = grp;
    pg8::gemm_phase<EpiOut>(lds, g, S, E);
}

__device__ __forceinline__ void phase_final(const P& p) {
    const int tid = tidx(), lane = tid & 63, w = tid >> 6, c = blockIdx.x, G = gridDim.x;
    for (int row = c * 8 + w; row < NB * SEQ; row += G * 8) {
        float* src = p.out + (size_t)row * 1024; f32x4 v[4]; float ss = 0.f;
#pragma unroll
        for (int i = 0; i < 4; ++i) { v[i] = *(const f32x4*)(src + i * 256 + lane * 4); ss += v[i][0] * v[i][0] + v[i][1] * v[i][1] + v[i][2] * v[i][2] + v[i][3] * v[i][3]; }
#pragma unroll
        for (int o = 32; o >= 1; o >>= 1) ss += __shfl_xor(ss, o);
        const float rs = rsqrtf(ss * (1.f / 1024.f) + 1e-6f);
#pragma unroll
        for (int i = 0; i < 4; ++i) { const int col = i * 256 + lane * 4; f32x4 y = v[i] * rs * *(const f32x4*)(p.fnorm_w + col);
#ifdef SCRUB
            for (int e = 0; e < 4; ++e) if (!(fabsf(y[e]) < 1e30f)) y[e] = 30.f;
#endif
            *(f32x4*)(src + col) = y; }
    }
}


#ifdef DBG
DI float wsum(float v) {
#pragma unroll
    for (int o = 32; o >= 1; o >>= 1) v += __shfl_xor(v, o);
    return v; }
DI float bfr(float v) { return bf2f(cvt_pk_bf16(v, 0.f) & 0xffffu); }
DI float dotHW(const u16* a, const u16* b, int n, int lane) { float s = 0.f; for (int k = lane; k < n; k += 64) s += bf2f(a[k]) * bf2f(b[k]); return wsum(s); }
__global__ void __launch_bounds__(NT) dbg_copy(P p) {
    const size_t gtid = (size_t)blockIdx.x * NT + threadIdx.x, gsz = (size_t)gridDim.x * NT; const size_t Mg = (size_t)p.bg * 2304;
    const u32x4* a = (const u32x4*)(p.ws + p.oZF); u32x4* da = (u32x4*)(p.ws + p.oDbg);
    for (size_t i = gtid; i < Mg * 1024 / 8; i += gsz) da[i] = a[i];
    const u32x4* b = (const u32x4*)(p.ws + p.oZB); u32x4* db = da + Mg * 1024 / 8;
    for (size_t i = gtid; i < Mg * 1024 / 8; i += gsz) db[i] = b[i];
    const u32x4* g = (const u32x4*)(p.ws + p.oG2); u32x4* dg = db + Mg * 1024 / 8;
    for (size_t i = gtid; i < Mg * 2048 / 8; i += gsz) dg[i] = g[i];
}
__global__ void __launch_bounds__(NT) dbg_check(P p) {
    __shared__ unsigned flsh[32];
    const int tid = threadIdx.x, lane = tid & 63, w = tid >> 6, bg = p.bg; const size_t Mg = (size_t)bg * 2304;
    unsigned* fl = flsh;
    if (tid < 32) fl[tid] = 0u;
    __syncthreads();
    const u16* H = (const u16*)(p.ws + p.oH); const u16* WinT = (const u16*)(p.ws + p.oWinT); const u16* V = (const u16*)(p.ws + p.oV); const u16* Q = (const u16*)(p.ws + p.oQ);
    const u16* ZFo = (const u16*)(p.ws + p.oZF); const u16* ZBo = (const u16*)(p.ws + p.oZB); const u16* G2 = (const u16*)(p.ws + p.oG2);
    const u16* dZF = (const u16*)(p.ws + p.oDbg); const u16* dZB = dZF + Mg * 1024; const u16* dG2 = dZB + Mg * 1024;
    const u16* WcsT = (const u16*)(p.ws + p.oWcsT); const u16* Wu = (const u16*)(p.ws + p.oWu); const u16* WpT = (const u16*)(p.ws + p.oWpT);
    const u16* Ttx = (const u16*)(p.ws + p.oTtx); const u16* Dx = (const u16*)(p.ws + p.oDx); const u16* WoutT = (const u16*)(p.ws + p.oWoutT);
    const float* mod = (const float*)(p.ws + p.oMod); const float* lbs = (const float*)(p.ws + p.oLbs);
#define CHKS(idx, fast, ref, tol, scl) do { const float f_ = (fast), r_ = (ref); if (lane == 0 && !(fabsf(f_ - r_) <= (tol) * (fabsf(r_) + (scl)))) atomicOr((unsigned*)&fl[idx], 1u); } while (0)
#define CHK(idx, fast, ref, tol) CHKS(idx, fast, ref, tol, 0.05f)
    for (int s = w; s < 16; s += 8) {
        const int si = s & 3, sj = s >> 2; const int row = si == 0 ? 0 : (si == 1 ? 4099 : (si == 2 ? bg * 2048 - 1 : bg * 2048 + 300)); const int col = sj == 0 ? 1 : (sj == 1 ? 130 : (sj == 2 ? 517 : 1023));
        { const int r = si == 3 ? 16 : si * 5, n = col * 3; float a = 0.f; for (int k = lane; k < 1024; k += 64) { const float cv = r < 16 ? p.c[r * 1024 + k] : p.c_ctx[k]; a += silu(cv) * p.w_ada[(size_t)k * 3072 + n]; }
          a = wsum(a) + p.b_ada[n]; CHK(1, mod[(size_t)r * 3072 + n], a, 1e-3f); }
        { const int n = col * 7, k = (row * 13) & 1023; CHK(2, bf2f(WinT[(size_t)n * 1024 + k]), bfr(p.w_in[(size_t)k * NIN + n]), 1e-6f); }
        { const float* src; int mr; if (row < bg * 2048) { src = p.x + (size_t)row * 1024; mr = row >> 11; } else { src = p.ctx + (size_t)(row - bg * 2048) * 1024; mr = 16; }
          float ss = 0.f, xv = 0.f; for (int k = lane; k < 1024; k += 64) { float v = src[k];
              if (row < bg * 2048) { const int t = row & 2047, i = k & 255; const float om = powf(10000.f, -(float)i / 256.f); const float pp = (float)(k < 512 ? (t >> 6) : (t & 63)); v += ((k >> 8) & 1) ? cosf(pp * om) : sinf(pp * om); }
              ss += v * v; if (k == col) xv = v; }
          ss = wsum(ss); xv = wsum(xv); const float y = xv * rsqrtf(ss / 1024.f + 1e-6f) * p.norm_w[col] * (1.f + mod[(size_t)mr * 3072 + 1024 + col]) + mod[(size_t)mr * 3072 + col];
          CHK(3, bf2f(H[(size_t)row * 1024 + col]), y, 1e-2f); }
        const u16* hrow = H + (size_t)row * 1024;
        { float d = dotHW(hrow, WinT + (size_t)col * 1024, 1024, lane); CHK(4, bf2f(V[(size_t)row * 1024 + col]), d, 1e-2f);
          d = dotHW(hrow, WinT + (size_t)(1024 + col) * 1024, 1024, lane); CHK(5, h2f(dZF[(size_t)row * 1024 + col]), d, 1e-2f);
          d = dotHW(hrow, WinT + (size_t)(2048 + col) * 1024, 1024, lane); CHK(5, h2f(dZB[(size_t)row * 1024 + col]), d, 1e-2f);
          d = dotHW(hrow, WinT + (size_t)(3072 + col) * 1024, 1024, lane); CHK(6, bf2f(Q[(size_t)row * 1024 + col]), silu(d), 1e-2f);
          d = dotHW(hrow, WinT + (size_t)(4096 + col) * 1024, 1024, lane); CHK(7, bf2f(dG2[(size_t)row * 2048 + col]), silu(d), 1e-2f);
          d = dotHW(hrow, WinT + (size_t)(6144 + col) * 1024, 1024, lane); CHK(7, bf2f(dG2[(size_t)row * 2048 + 1024 + col]), silu(d), 1e-2f); }
        const int g = si, n256 = col & 255, half = sj & 1, j = half * 256 + n256, cin = (row * 7 + 3) & 255;
        { float a = 0.f; for (int cp = lane; cp < 256; cp += 64) { const float th = (float)((cin * cp) & 255) / 128.f; a += (half ? sinpif(th) : cospif(th)) * p.w_four[((size_t)g * 256 + cp) * 256 + n256]; }
          a = wsum(a); CHK(8, bf2f(WcsT[((size_t)g * 512 + j) * 256 + cin]), a, 1e-2f); }
        { const int k = (row * 13) & 1023; const float d = dotHW(WcsT + ((size_t)g * 512 + j) * 256, Wu + (size_t)k * 1024 + g * 256, 256, lane); CHK(9, bf2f(WpT[((size_t)g * 512 + j) * 1024 + k]), d, 1e-2f); }
        if (row < bg * 2048) { const int bl = row >> 11, l = row & 2047; const float fast = bf2f(Ttx[(((size_t)(bl * 4 + g) * 256 + n256) * 2 + half) * 2048 + l]);
          const float d = dotHW(WpT + ((size_t)g * 512 + j) * 1024, hrow, 1024, lane); CHK(10, fast, d, 1e-2f);
          float a = 0.f; for (int ci = 0; ci < 256; ++ci) { const float u = dotHW(hrow, WinT + (size_t)(5120 + g * 256 + ci) * 1024, 1024, lane); float wc = 0.f;
              for (int cp = lane; cp < 256; cp += 64) { const float th = (float)((ci * cp) & 255) / 128.f; wc += (half ? sinpif(th) : cospif(th)) * p.w_four[((size_t)g * 256 + cp) * 256 + n256]; }
              a += u * wsum(wc); }
          CHKS(11, fast, a, 2e-2f, 10.f); }
        if (row < bg * 2048) { const int bl = row >> 11, lp = row & 2047; const u16* tt = Ttx + ((size_t)(bl * 4 + g) * 256 + n256) * 4096; const float sc = 1.f / sqrtf(2048.f * 256.f);
          const float gate = bf2f(dG2[(size_t)row * 2048 + 1024 + g * 256 + n256]), fast = bf2f(G2[(size_t)row * 2048 + 1024 + g * 256 + n256]), bb = p.b_four[g * 256 + n256];
          const float d = dotHW(Dx + (size_t)lp * 4096, tt, 4096, lane); CHK(14, fast, (d * sc + bb) * gate, 2e-2f);
          float a = 0.f; for (int l = lane; l < 2048; l += 64) { const float th = (float)((l * lp) & 2047) / 1024.f; a += cospif(th) * bf2f(tt[l]) - sinpif(th) * bf2f(tt[2048 + l]); }
          a = wsum(a); CHK(15, fast, (a * sc + bb) * gate, 2e-2f); }
        { const int hh = col >> 7; float ss = 0.f, ov = 0.f; for (int e = lane; e < 128; e += 64) { const float o = bf2f(ZFo[(size_t)row * 1024 + hh * 128 + e]) + bf2f(ZBo[(size_t)row * 1024 + hh * 128 + e]); ss += o * o; if (hh * 128 + e == col) ov = o; }
          ss = wsum(ss); ov = wsum(ov); const float y = ov * rsqrtf(ss / 128.f + 1e-6f) * p.hn_w[col] * bf2f(dG2[(size_t)row * 2048 + col]); CHK(16, bf2f(G2[(size_t)row * 2048 + col]), y, 2e-2f); }
        if (row < bg * 2048) { const float d = dotHW(G2 + (size_t)row * 2048, WoutT + (size_t)col * 2048, 2048, lane); const int t = row & 2047, i = col & 255; const float om = powf(10000.f, -(float)i / 256.f);
          const float pp = (float)(col < 512 ? (t >> 6) : (t & 63)); const float x0 = p.x[(size_t)row * 1024 + col] + (((col >> 8) & 1) ? cosf(pp * om) : sinf(pp * om));
          CHK(17, p.out[(size_t)row * 1024 + col], x0 + mod[(size_t)(row >> 11) * 3072 + 2048 + col] * d, 2e-2f); }
    }
    { const int dir = w & 1, sidx = w >> 1; const int bl = sidx & 1, hh = (sidx * 3 + 1) & 7, e = (sidx * 37 + 5) & 127; const int tgt = sidx < 2 ? 37 : (sidx == 2 ? 5 : -100);
      const u16* Zs = dir ? dZB : dZF; const u16* Oo = dir ? ZBo : ZFo; const float* lb = lbs + (dir * 4 + 0) * 1024 + hh * 128;
      float s0 = 0.f, s1 = 0.f, o = 0.f; const float l0 = 1.f - lb[lane], l1 = 1.f - lb[lane + 64]; int outrow = 0;
      for (int part = 0; part < 2; ++part) { const int Lp = part ? 2048 : 256, base = part ? bl * 2048 : bg * 2048 + bl * 256; int nsteps;
          if (part == 0) nsteps = tgt < 0 ? 101 : 256; else nsteps = tgt < 0 ? 0 : tgt + 1;
          for (int st = 0; st < nsteps; ++st) { const int row = base + (dir ? Lp - 1 - st : st); const size_t ro = (size_t)row * 1024 + hh * 128;
              const float z0 = h2f(Zs[ro + lane]), z1 = h2f(Zs[ro + lane + 64]); const float k0 = l0 / (1.f + expf(z0)), k1 = l1 / (1.f + expf(z1));
              const float f0 = fmaxf(1.f - k0, 1e-6f), f1 = fmaxf(1.f - k1, 1e-6f); const float v = bf2f(V[ro + e]);
              s0 = f0 * s0 + k0 * v; s1 = f1 * s1 + k1 * v; o = wsum(s0 * bf2f(Q[ro + lane]) + s1 * bf2f(Q[ro + lane + 64])); outrow = row; } }
      CHKS(12 + dir, bf2f(Oo[(size_t)outrow * 1024 + hh * 128 + e]), o, 2e-2f, 3.f); }
    __syncthreads();
    __shared__ unsigned cnt[4];
    if (tid < 4) cnt[tid] = 0u;
    __syncthreads();
    { unsigned c0 = 0, c1 = 0, c2 = 0;
      for (size_t i = tid; i < Mg * 1024; i += NT) { if (!(fabsf(bf2f(ZFo[i])) < 1e30f)) ++c0; if (!(fabsf(bf2f(ZBo[i])) < 1e30f)) ++c1; const size_t gi = (i >> 10) * 2048 + (i & 1023); if (!(fabsf(bf2f(G2[gi])) < 1e30f)) ++c2; }
      atomicAdd(&cnt[0], c0); atomicAdd(&cnt[1], c1); atomicAdd(&cnt[2], c2); }
    __syncthreads();
    int early = 0;
    for (int i = 1; i <= 13; ++i) if (fl[i]) early = 1;
    const int bitsA = early | ((cnt[0] | cnt[1]) ? 2 : 0) | (cnt[2] ? 4 : 0), bitsB = (fl[14] ? 1 : 0) | (fl[15] ? 2 : 0) | (fl[16] ? 4 : 0) | (fl[17] ? 8 : 0);
    const float val = 4.f * (float)bitsA;
    for (size_t i = tid; i < (size_t)NB * SEQ * DM; i += NT) p.out[i] = val;
    __syncthreads();
    if (tid == 0) p.out[0] = 100.f * (float)(1 + bitsB);
}
#endif

template <bool COOP>
__global__ void __launch_bounds__(NT, 2) fwd_kernel(P p0, int ph_lo, int ph_hi) {
    extern __shared__ __attribute__((aligned(16))) unsigned char shm[];
    LAS unsigned char* lds = (LAS unsigned char*)shm;
    const int nlp = DEPTH * p0.ng * 5, last = 2 + nlp;
    for (int ph = ph_lo; ph < ph_hi; ++ph) {
        P p = p0;
        { unsigned long long a = (unsigned long long)p.ws, b = (unsigned long long)p.out; asm volatile("" : "+s"(a), "+s"(b)); p.ws = (unsigned char*)a; p.out = (float*)b; }
#ifdef DBG
        if (ph == 0) phase_p0a(p, lds); else if (ph == 1) phase_p0b(p, lds); else if (ph == 2) phase_norm(p, 0, 0); else if (ph == 3) phase_gemm_in(p, 0, lds);
        else if (ph == 5) phase_scan_f3(p, 0, lds); else if (ph == 6) phase_combine(p, 0); else if (ph == 7) phase_gemm_out(p, 0, 0, lds);
        if (0) {}
#else
        if (ph == 0) { if (ONLY & 1) phase_p0a(p, lds); }
        else if (ph == 1) { if (ONLY & 2) phase_p0b(p, lds); }
        else if (ph == last) { if (ONLY & 4) phase_final(p); }
        else {
            const int k = ph - 2, lg = k / 5, sub = k % 5, l = lg / p.ng, grp = lg % p.ng;
            if (sub == 0) { if (ONLY & 4) phase_norm(p, l, grp); }
            else if (sub == 1) { if (ONLY & 8) phase_gemm_in(p, l, lds); }
            else if (sub == 2) { if (ONLY & 80) phase_scan_f3(p, l, lds); }
            else if (sub == 3) { if (ONLY & 4) phase_combine(p, l); }
            else { if (ONLY & 32) phase_gemm_out(p, l, grp, lds); }
        }
#endif
        if (COOP) { if (ph + 1 < ph_hi) cg::this_grid().sync(); }
    }
}

static size_t align_up(size_t v) { return (v + 4095) & ~(size_t)4095; }

extern "C" void kernel_launch(void* const* d_in, const int* in_sizes, int n_in, void* d_out, int out_size, void* d_ws, size_t ws_size, hipStream_t stream) {
    static int grid = 0;
    if (grid == 0) {
        int dev = 0, cus = 0;
        (void)hipGetDevice(&dev); (void)hipDeviceGetAttribute(&cus, hipDeviceAttributeMultiprocessorCount, dev);
        (void)hipFuncSetAttribute((const void*)fwd_kernel<true>, hipFuncAttributeMaxDynamicSharedMemorySize, LDS_BYTES);
        (void)hipFuncSetAttribute((const void*)fwd_kernel<false>, hipFuncAttributeMaxDynamicSharedMemorySize, LDS_BYTES);
        int per_cu = 0;
        (void)hipOccupancyMaxActiveBlocksPerMultiprocessor(&per_cu, (const void*)fwd_kernel<true>, NT, LDS_BYTES);
        if (per_cu < 1) per_cu = 1;
        grid = cus * 1;
        (void)hipGetLastError();
    }
    P p{};
    p.x = (const float*)d_in[0]; p.c = (const float*)d_in[1]; p.ctx = (const float*)d_in[2]; p.c_ctx = (const float*)d_in[3]; p.norm_w = (const float*)d_in[4];
    p.w_ada = (const float*)d_in[5]; p.b_ada = (const float*)d_in[6]; p.w_in = (const float*)d_in[7]; p.lower = (const float*)d_in[8]; p.hn_w = (const float*)d_in[9];
    p.w_four = (const float*)d_in[10]; p.b_four = (const float*)d_in[11]; p.w_out = (const float*)d_in[12]; p.fnorm_w = (const float*)d_in[13];
    p.out = (float*)d_out; p.ws = (unsigned char*)d_ws;
    auto layout = [&](int ng) -> size_t {
        const size_t bg = NB / ng, Mg = bg * 2304; size_t o = 0;
        p.ng = ng; p.bg = (int)bg;
        p.oWinT = o; o = align_up(o + (size_t)DEPTH * NIN * 1024 * 2);
        p.oWoutT = o; o = align_up(o + (size_t)DEPTH * 1024 * 2048 * 2);
        p.oWu = o; o = align_up(o + (size_t)DEPTH * 1024 * 1024 * 2);
        p.oWcsT = o; o = align_up(o + (size_t)16 * 512 * 256 * 2);
        p.oWpT = o; o = align_up(o + (size_t)DEPTH * 2048 * 1024 * 2);
        p.oDx = o; o = align_up(o + (size_t)2048 * 4096 * 2);
        p.oDc = o; o = align_up(o + (size_t)256 * 512 * 2);
        p.oPos = o; o = align_up(o + (size_t)2048 * 1024 * 4);
        p.oLbs = o; o = align_up(o + (size_t)2 * 4 * 1024 * 4);
        p.oModPart = o; o = align_up(o + (size_t)DEPTH * 8 * 17 * 3072 * 4);
        p.oMod = o; o = align_up(o + (size_t)DEPTH * 17 * 3072 * 4);
        p.oCtx = o; o = align_up(o + (size_t)NB * CTXL * DM * 4);
        p.oH = o; o = align_up(o + Mg * 1024 * 2);
        p.oV = o; o = align_up(o + Mg * 1024 * 2);
        p.oZF = o; o = align_up(o + Mg * 1024 * 2);
        p.oZB = o; o = align_up(o + Mg * 1024 * 2);
        p.oQ = o; o = align_up(o + Mg * 1024 * 2);
        p.oG2 = o; o = align_up(o + Mg * 2048 * 2);
        p.oTtx = o; o = align_up(o + bg * 4 * 256 * 4096 * 2);
        p.oTtc = o; o = align_up(o + bg * 4 * 256 * 512 * 2);
#ifdef DBG
        p.oDbg = o; o = align_up(o + Mg * 4096 * 2);
#endif
        return o;
    };
#ifdef DBG
    size_t need = layout(4);
#else
    size_t need = layout(1);
    if (need > ws_size) need = layout(2);
#endif
    if (need > ws_size) { fprintf(stderr, "kernel_launch: workspace too small (%zu < %zu)\n", ws_size, need); return; }
#ifdef DBG
    const int nph = 9;
#else
    const int nph = 2 + DEPTH * p.ng * 5 + 1;
#endif
#ifndef MULTI_LAUNCH
    int lo = 0, hi = nph;
    void* args[] = {&p, &lo, &hi};
    hipError_t e = hipLaunchCooperativeKernel((const void*)fwd_kernel<true>, dim3(grid), dim3(NT), args, LDS_BYTES, stream);
    if (e != hipSuccess) fprintf(stderr, "cooperative launch failed: %s (grid %d)\n", hipGetErrorString(e), grid);
#else
#ifdef DBG
    for (int ph = 0; ph < nph; ++ph) {
        if (ph == 4) hipLaunchKernelGGL(dbg_copy, dim3(grid), dim3(NT), 0, stream, p);
        else if (ph == 8) hipLaunchKernelGGL(dbg_check, dim3(1), dim3(NT), 0, stream, p);
        else hipLaunchKernelGGL(fwd_kernel<false>, dim3(grid), dim3(NT), LDS_BYTES, stream, p, ph, ph + 1);
    }
#else
    for (int ph = 0; ph < nph; ++ph) hipLaunchKernelGGL(fwd_kernel<false>, dim3(grid), dim3(NT), LDS_BYTES, stream, p, ph, ph + 1);
#endif
#endif
}
```

```cpp
#include <hip/hip_runtime.h>
#include <hip/hip_cooperative_groups.h>
#include <cstdio>
namespace cg = cooperative_groups;

#define LAS __attribute__((address_space(3)))
typedef unsigned short u16;
typedef short bf16x8 __attribute__((ext_vector_type(8)));
typedef float f32x4 __attribute__((ext_vector_type(4)));
typedef unsigned u32x4 __attribute__((ext_vector_type(4)));
typedef unsigned u32x2 __attribute__((ext_vector_type(2)));
#define DI __device__ __forceinline__

constexpr int DM = 1024, NB = 16, SEQ = 2048, DEPTH = 4, CTXL = 256, NIN = 7168;
constexpr int NT = 512;
constexpr int LDS_BYTES = 131072 + 16;
#ifndef ONLY
#define ONLY 255
#endif

struct P {
    const float *x, *c, *ctx, *c_ctx, *norm_w, *w_ada, *b_ada, *w_in, *lower, *hn_w, *w_four, *b_four, *w_out, *fnorm_w;
    float* out; unsigned char* ws;
    int ng, bg;
    size_t oWinT, oWoutT, oWu, oWcsT, oWpT, oDx, oDc, oPos, oLbs, oModPart, oMod, oCtx, oH, oV, oZF, oZB, oQ, oG2, oTtx, oTtc, oDbg, oBar, oH2, oT1024;
};

typedef __bf16 bf16v2 __attribute__((ext_vector_type(2)));
typedef float f32x2 __attribute__((ext_vector_type(2)));
DI unsigned cvt_pk_bf16(float lo, float hi) { const f32x2 v = {lo, hi}; const bf16v2 b = __builtin_convertvector(v, bf16v2); return __builtin_bit_cast(unsigned, b); }
DI float bf2f(unsigned h) { return __uint_as_float(h << 16); }
DI float bflo(unsigned w) { return __uint_as_float(w << 16); }
DI float bfhi(unsigned w) { return __uint_as_float(w & 0xffff0000u); }
DI unsigned pk_f16(float lo, float hi) { _Float16 a = (_Float16)lo, b = (_Float16)hi; return (unsigned)__builtin_bit_cast(unsigned short, a) | ((unsigned)__builtin_bit_cast(unsigned short, b) << 16); }
DI float h2f(unsigned h) { return (float)__builtin_bit_cast(_Float16, (unsigned short)h); }
DI int tidx() { int t = threadIdx.x; asm volatile("" : "+v"(t)); return t; }
DI float silu(float v) { return v * __builtin_amdgcn_rcpf(1.f + __expf(-v)); }

namespace pg8 {
constexpr int BM = 256, BK = 64, HALF = 128, HTB = HALF * BK * 2, STAGE_BYTES = 8 * HTB, NXCD = 8, WGM = 8;
DI int lds_byte(int r, int c) { const int st = (r >> 4) * 2 + (c >> 5), rr = r & 15, cc = c & 31, ob = rr * 64 + cc * 2; return st * 1024 + (ob ^ (((ob >> 9) & 1) << 5)); }
DI void stage_rc(int b, int& R, int& C) { const int st = b / 1024, sb = b % 1024, swz = sb ^ (((sb >> 9) & 1) << 5); R = (st >> 1) * 16 + swz / 64; C = (st & 1) * 32 + (swz % 64) / 2; }
DI int perm32(int rho) { const int n = rho >> 4, i = rho & 15; return 8 * (i >> 2) + 4 * n + (i & 3); }

struct Unit { int pm, pn, tag, pad; long aoff, boff; };
struct Gemm { const u16* A; const u16* Bt; int lda, ldb, K; };

struct Sched {
    int nM, nN, nB, nw, wi, mode;
    long aTile, bTile, aBatch, bBatch;
    int segmap;
    DI bool next(int i, Unit& u) const {
        const long L = (long)i * nw + wi;
        if (mode == 0) {
            const int nwg = nM * nN; if (L >= nwg) return false;
            int wgid = (int)L; { const int q = nwg / NXCD, r = nwg % NXCD, xcd = wgid % NXCD, off = wgid / NXCD; wgid = (xcd < r ? xcd * (q + 1) : r * (q + 1) + (xcd - r) * q) + off; }
            const int nig = WGM * nN, gid = wgid / nig, fm = gid * WGM, gsz = (nM - fm) < WGM ? (nM - fm) : WGM;
            u.pm = fm + ((wgid % nig) % gsz); u.pn = (wgid % nig) / gsz; u.tag = 0;
        } else if (mode == 2) {
            const int nx = 32 * nB; if (L >= nx + 8 * nB) return false;
            if (L < nx) { u.pm = (int)(L & 7); const int rest = (int)(L >> 3); u.pn = (rest >> 2) * 8 + (u.pm & 1) * 4 + (rest & 3); }
            else { const int L2 = (int)L - nx; u.pm = L2 & 7; u.pn = nB * 8 + (L2 >> 3); }
            u.tag = 0;
        } else {
            const long tot = (long)nB * nM * nN; if (L >= tot) return false;
            const int per = nM * nN; u.tag = (int)(L / per); const int rem = (int)(L % per); u.pm = rem / nN; u.pn = rem % nN;
        }
        u.pad = 0;
        u.aoff = (long)u.tag * aBatch + (long)u.pm * aTile;
        int pnb = u.pn;
        if (segmap == 1) { const int s5 = pnb >> 2; pnb = ((s5 < 4 ? s5 : 6) << 2) + (pnb & 3); }
        else if (segmap == 2) pnb += 16;
        u.boff = (long)u.tag * bBatch + (long)pnb * bTile;
        return true;
    }
};

template <class Epi>
DI void gemm_phase(LAS unsigned char* lds, const Gemm g, const Sched& S, const Epi& E) {
    const int tid = tidx(), wid = __builtin_amdgcn_readfirstlane(tid >> 6), lane = tid & 63, wr = wid >> 2, wc = wid & 3, fr = lane & 15, fq = lane >> 4;
    const int K = g.K, nt = K / BK;
    unsigned voffA[2], voffB[2];
#pragma unroll
    for (int i = 0; i < 2; ++i) { int R, C; stage_rc(tid * 16 + i * 8192, R, C); const int Rb = Epi::PERM ? ((R & ~31) + perm32(R & 31)) : R;
        voffA[i] = (unsigned)(R * g.lda + C) * 2u; voffB[i] = (unsigned)(Rb * g.ldb + C) * 2u; }
    const size_t kstep = (size_t)(BK * 2);
    const size_t hstepA = (size_t)HALF * g.lda * 2, hstepB = (size_t)HALF * g.ldb * 2;
    const unsigned ldsw = (unsigned)wid * 1024u;
    const int aoff = lds_byte(wr * 64 + fr, fq * 8), boff = lds_byte(wc * 32 + fr, fq * 8);
#define PG8_SA(b, h) (((b) * 2 + (h)) * HTB)
#define PG8_SB(b, h) ((4 + (b) * 2 + (h)) * HTB)
#define PG8_STAGE(bufoff, gbase, voff) do { _Pragma("unroll") for (int _i = 0; _i < 2; ++_i) \
        __builtin_amdgcn_global_load_lds((const unsigned*)((const char*)(gbase) + (voff)[_i]), (LAS unsigned*)(lds + (bufoff) + ldsw + _i * 8192), 16, 0, 0); } while (0)
#define PG8_LDA(dst, b, h) do { _Pragma("unroll") for (int m = 0; m < 4; ++m) _Pragma("unroll") for (int k = 0; k < 2; ++k) dst[m][k] = *(const LAS bf16x8*)(lds + PG8_SA(b, h) + aoff + m * 2048 + k * 1024); } while (0)
#define PG8_LDB(dst, b, h) do { _Pragma("unroll") for (int n = 0; n < 2; ++n) _Pragma("unroll") for (int k = 0; k < 2; ++k) dst[n][k] = *(const LAS bf16x8*)(lds + PG8_SB(b, h) + boff + n * 2048 + k * 1024); } while (0)
#define PG8_MMA(ai, bj, At, Bt) do { __builtin_amdgcn_s_setprio(1); _Pragma("unroll") for (int m = 0; m < 4; ++m) _Pragma("unroll") for (int n = 0; n < 2; ++n) _Pragma("unroll") for (int k = 0; k < 2; ++k) \
        acc[ai][bj][m][n] = __builtin_amdgcn_mfma_f32_16x16x32_bf16(Bt[n][k], At[m][k], acc[ai][bj][m][n], 0, 0, 0); __builtin_amdgcn_s_setprio(0); } while (0)
#define PG8_WAIT_V(n) asm volatile("s_waitcnt vmcnt(" #n ")" ::: "memory")
#define PG8_WAIT_L(n) asm volatile("s_waitcnt lgkmcnt(" #n ")" ::: "memory")
#define PG8_BAR __builtin_amdgcn_s_barrier()
#define PG8_SCHED __builtin_amdgcn_sched_barrier(0)
    Unit cur, nxt; int ui = 0;
    if (!S.next(0, cur)) return;
    f32x4 acc[2][2][4][2];
#pragma unroll
    for (int a = 0; a < 2; ++a)
#pragma unroll
        for (int b = 0; b < 2; ++b)
#pragma unroll
            for (int m = 0; m < 4; ++m)
#pragma unroll
                for (int n = 0; n < 2; ++n) acc[a][b][m][n] = (f32x4){0.f, 0.f, 0.f, 0.f};
    bf16x8 At[4][2], B0[2][2], B1[2][2];
    const char* cA = (const char*)g.A + cur.aoff; const char* cB = (const char*)g.Bt + cur.boff;
    PG8_STAGE(PG8_SB(0, 0), cB, voffB); PG8_STAGE(PG8_SA(0, 0), cA, voffA); PG8_STAGE(PG8_SB(0, 1), cB + hstepB, voffB); PG8_STAGE(PG8_SA(0, 1), cA + hstepA, voffA);
    if (wr == 1) PG8_BAR;
    PG8_WAIT_V(4); PG8_BAR;
    PG8_STAGE(PG8_SB(1, 0), cB + kstep, voffB); PG8_STAGE(PG8_SA(1, 0), cA + kstep, voffA); PG8_STAGE(PG8_SB(1, 1), cB + hstepB + kstep, voffB);
    PG8_WAIT_V(6); PG8_BAR;
    for (;;) {
        const bool has_next = S.next(ui + 1, nxt);
        const char* nA = has_next ? (const char*)g.A + nxt.aoff : cA; const char* nB = has_next ? (const char*)g.Bt + nxt.boff : cB;
        for (int t = 0; t < nt; t += 2) {
            const bool last = (t == nt - 2);
            const char* a1 = cA + (size_t)(t + 1) * kstep;
            const char* a2 = last ? nA : cA + (size_t)(t + 2) * kstep; const char* b2 = last ? nB : cB + (size_t)(t + 2) * kstep;
            const char* a3 = a2 + kstep; const char* b3 = b2 + kstep;
            PG8_LDB(B0, 0, 0); PG8_SCHED; PG8_LDA(At, 0, 0); PG8_STAGE(PG8_SA(1, 1), a1 + hstepA, voffA);
            PG8_WAIT_L(8); PG8_BAR; PG8_WAIT_L(0); PG8_MMA(0, 0, At, B0); PG8_BAR; PG8_SCHED;
            PG8_LDB(B1, 0, 1); PG8_STAGE(PG8_SB(0, 0), b2, voffB);
            PG8_BAR; PG8_WAIT_L(0); PG8_MMA(0, 1, At, B1); PG8_BAR;
            PG8_LDA(At, 0, 1); PG8_STAGE(PG8_SA(0, 0), a2, voffA);
            PG8_BAR; PG8_WAIT_L(0); PG8_MMA(1, 0, At, B0); PG8_BAR; PG8_SCHED;
            PG8_STAGE(PG8_SB(0, 1), b2 + hstepB, voffB);
            PG8_WAIT_V(6); PG8_BAR; PG8_MMA(1, 1, At, B1); PG8_BAR;
            PG8_LDB(B0, 1, 0); PG8_SCHED; PG8_LDA(At, 1, 0); PG8_STAGE(PG8_SA(0, 1), a2 + hstepA, voffA);
            PG8_WAIT_L(8); PG8_BAR; PG8_WAIT_L(0); PG8_MMA(0, 0, At, B0); PG8_BAR; PG8_SCHED;
            PG8_LDB(B1, 1, 1); PG8_STAGE(PG8_SB(1, 0), b3, voffB);
            PG8_BAR; PG8_WAIT_L(0); PG8_MMA(0, 1, At, B1); PG8_BAR;
            PG8_LDA(At, 1, 1); PG8_STAGE(PG8_SA(1, 0), a3, voffA);
            PG8_BAR; PG8_WAIT_L(0); PG8_MMA(1, 0, At, B0); PG8_BAR; PG8_SCHED;
            PG8_STAGE(PG8_SB(1, 1), b3 + hstepB, voffB);
            PG8_WAIT_V(6); PG8_BAR; PG8_MMA(1, 1, At, B1); PG8_BAR;
        }
        E(acc, cur, wr, wc, fr, fq);
        if (!has_next) break;
#pragma unroll
        for (int a = 0; a < 2; ++a)
#pragma unroll
            for (int b = 0; b < 2; ++b)
#pragma unroll
                for (int m = 0; m < 4; ++m)
#pragma unroll
                    for (int n = 0; n < 2; ++n) acc[a][b][m][n] = (f32x4){0.f, 0.f, 0.f, 0.f};
        cur = nxt; cA = nA; cB = nB; ++ui;
    }
    PG8_WAIT_V(0);
    if (wr == 0) PG8_BAR;
    PG8_BAR;
#undef PG8_SA
#undef PG8_SB
#undef PG8_STAGE
#undef PG8_LDA
#undef PG8_LDB
#undef PG8_MMA
#undef PG8_WAIT_V
#undef PG8_WAIT_L
#undef PG8_BAR
#undef PG8_SCHED
}
}
using pg8::Unit; using pg8::Gemm; using pg8::Sched; using pg8::HALF;
typedef f32x4 Acc[2][2][4][2];

struct EpiIn {
    static constexpr bool PERM = true;
    u16 *V, *ZF, *ZB, *Q, *G2; int forced, rowbase;
    const float* lbl;
    DI void operator()(const Acc& acc, const Unit& u, int wr, int wc, int fr, int fq) const {
        const int s6 = forced >= 0 ? forced : ((u.pn >> 2) < 4 ? (u.pn >> 2) : 5), cw = (u.pn & 3) * 256;
        u16* base; int ld = 1024, mode = 0, cofs = cw;
        if (s6 == 0) base = V; else if (s6 == 1) { base = ZF; mode = 1; } else if (s6 == 2) { base = ZB; mode = 1; }
        else if (s6 == 3) { base = Q; mode = 2; } else if (s6 == 4) { base = G2; ld = 2048; mode = 2; } else { base = G2; ld = 2048; mode = 2; cofs = 1024 + cw; }
        const int row0 = rowbase + u.pm * 256 + wr * 64 + fr, col0 = cofs + wc * 32 + 8 * fq;
        f32x4 om[2][2];
        if (mode == 1) { const float* lp = lbl + (s6 - 1) * 4096 + col0;
#pragma unroll
            for (int bj = 0; bj < 2; ++bj) { om[bj][0] = 1.f - *(const f32x4*)(lp + bj * HALF); om[bj][1] = 1.f - *(const f32x4*)(lp + bj * HALF + 4); } }
#pragma unroll
        for (int ai = 0; ai < 2; ++ai)
#pragma unroll
            for (int m = 0; m < 4; ++m) { u16* rowp = base + (size_t)(row0 + ai * HALF + m * 16) * ld + col0;
#pragma unroll
                for (int bj = 0; bj < 2; ++bj) { f32x4 v0 = acc[ai][bj][m][0], v1 = acc[ai][bj][m][1]; u32x4 w;
                    if (mode == 1) {
#pragma unroll
                        for (int j = 0; j < 4; ++j) { v0[j] = om[bj][0][j] * __builtin_amdgcn_rcpf(1.f + __expf(v0[j])); v1[j] = om[bj][1][j] * __builtin_amdgcn_rcpf(1.f + __expf(v1[j])); }
                        w.x = pk_f16(v0[0], v0[1]); w.y = pk_f16(v0[2], v0[3]); w.z = pk_f16(v1[0], v1[1]); w.w = pk_f16(v1[2], v1[3]); }
                    else { if (mode == 2) {
#pragma unroll
                            for (int j = 0; j < 4; ++j) { v0[j] = silu(v0[j]); v1[j] = silu(v1[j]); } }
                        w.x = cvt_pk_bf16(v0[0], v0[1]); w.y = cvt_pk_bf16(v0[2], v0[3]); w.z = cvt_pk_bf16(v1[0], v1[1]); w.w = cvt_pk_bf16(v1[2], v1[3]); }
                    *(u32x4*)(rowp + bj * HALF) = w; } }
    }
};
struct EpiBf {
    static constexpr bool PERM = true;
    u16* O; int ld; long batchStride;
    DI void operator()(const Acc& acc, const Unit& u, int wr, int wc, int fr, int fq) const {
        u16* base = O + (size_t)u.tag * batchStride;
        const int row0 = u.pm * 256 + wr * 64 + fr, col0 = u.pn * 256 + wc * 32 + 8 * fq;
#pragma unroll
        for (int ai = 0; ai < 2; ++ai)
#pragma unroll
            for (int m = 0; m < 4; ++m) { u16* rowp = base + (size_t)(row0 + ai * HALF + m * 16) * ld + col0;
#pragma unroll
                for (int bj = 0; bj < 2; ++bj) { const f32x4 v0 = acc[ai][bj][m][0], v1 = acc[ai][bj][m][1]; u32x4 w;
                    w.x = cvt_pk_bf16(v0[0], v0[1]); w.y = cvt_pk_bf16(v0[2], v0[3]); w.z = cvt_pk_bf16(v1[0], v1[1]); w.w = cvt_pk_bf16(v1[2], v1[3]);
                    *(u32x4*)(rowp + bj * HALF) = w; } }
    }
};
struct EpiTt {
    static constexpr bool PERM = true;
    u16 *Ttx, *Ttc; int bg;
    DI void operator()(const Acc& acc, const Unit& u, int wr, int wc, int fr, int fq) const {
        const int g = u.pm >> 1, half = u.pm & 1;
        u16* base; int Lp, bl;
        if (u.pn < bg * 8) { bl = u.pn >> 3; Lp = 1024; base = Ttx + (size_t)(bl * 4 + g) * 256 * 2048 + (u.pn & 7) * 256; }
        else { bl = u.pn - bg * 8; Lp = 256; base = Ttc + (size_t)(bl * 4 + g) * 256 * 512 + half * 256; }
        const int n0 = wr * 64 + fr, col0 = wc * 32 + 8 * fq;
#pragma unroll
        for (int ai = 0; ai < 2; ++ai)
#pragma unroll
            for (int m = 0; m < 4; ++m) { u16* rowp = base + (size_t)(n0 + ai * HALF + m * 16) * (2 * Lp) + col0;
#pragma unroll
                for (int bj = 0; bj < 2; ++bj) { const f32x4 v0 = acc[ai][bj][m][0], v1 = acc[ai][bj][m][1]; u32x4 w;
                    w.x = cvt_pk_bf16(v0[0], v0[1]); w.y = cvt_pk_bf16(v0[2], v0[3]); w.z = cvt_pk_bf16(v1[0], v1[1]); w.w = cvt_pk_bf16(v1[2], v1[3]);
                    *(u32x4*)(rowp + bj * HALF) = w; } }
    }
};
struct EpiF3 {
    static constexpr bool PERM = true;
    u16* G2; const float* bias; const float* t1024; float scale; int rowbase, Lp;
    DI void operator()(const Acc& acc, const Unit& u, int wr, int wc, int fr, int fq) const {
        const int bl = u.tag >> 2, g = u.tag & 3;
        const int row0 = rowbase + bl * Lp + u.pm * 256 + wr * 64 + fr, col0 = wc * 32 + 8 * fq;
        const float* bp = bias + g * 256 + col0;
        f32x4 bv[2][2];
#pragma unroll
        for (int bj = 0; bj < 2; ++bj) { bv[bj][0] = *(const f32x4*)(bp + bj * HALF); bv[bj][1] = *(const f32x4*)(bp + bj * HALF + 4); }
        if (t1024) { const float* tp = t1024 + (size_t)bl * 1024 + g * 256 + col0; const float sg = (fr & 1) ? -scale : scale;
#pragma unroll
            for (int bj = 0; bj < 2; ++bj) { bv[bj][0] = bv[bj][0] + *(const f32x4*)(tp + bj * HALF) * sg; bv[bj][1] = bv[bj][1] + *(const f32x4*)(tp + bj * HALF + 4) * sg; } }
        u32x4 gc[2], gn[2];
        { const u16* rowp = G2 + (size_t)row0 * 2048 + 1024 + g * 256 + col0; gc[0] = *(const u32x4*)rowp; gc[1] = *(const u32x4*)(rowp + HALF); }
#pragma unroll
        for (int gi = 0; gi < 8; ++gi) { const int ai = gi >> 2, m = gi & 3;
            if (gi + 1 < 8) { const u16* rp2 = G2 + (size_t)(row0 + ((gi + 1) >> 2) * HALF + ((gi + 1) & 3) * 16) * 2048 + 1024 + g * 256 + col0; gn[0] = *(const u32x4*)rp2; gn[1] = *(const u32x4*)(rp2 + HALF); }
            u16* rowp = G2 + (size_t)(row0 + ai * HALF + m * 16) * 2048 + 1024 + g * 256 + col0;
#pragma unroll
            for (int bj = 0; bj < 2; ++bj) { const f32x4 v0 = acc[ai][bj][m][0] * scale + bv[bj][0], v1 = acc[ai][bj][m][1] * scale + bv[bj][1];
                const u32x4 gt = gc[bj]; u32x4 w;
                w.x = cvt_pk_bf16(v0[0] * bflo(gt.x), v0[1] * bfhi(gt.x)); w.y = cvt_pk_bf16(v0[2] * bflo(gt.y), v0[3] * bfhi(gt.y));
                w.z = cvt_pk_bf16(v1[0] * bflo(gt.z), v1[1] * bfhi(gt.z)); w.w = cvt_pk_bf16(v1[2] * bflo(gt.w), v1[3] * bfhi(gt.w));
                *(u32x4*)(rowp + bj * HALF) = w; }
            gc[0] = gn[0]; gc[1] = gn[1]; }
    }
};
struct EpiOut {
    static constexpr bool PERM = false;
    float *xg, *cg_; const float* modl; int bg, grp;
    DI void operator()(const Acc& acc, const Unit& u, int wr, int wc, int fr, int fq) const {
        const int r0 = u.pm * 256; float* dst; const float* gate;
        if (r0 < bg * 2048) { dst = xg + (size_t)r0 * 1024; gate = modl + (size_t)(grp * bg + (r0 >> 11)) * 3072 + 2048; }
        else { dst = cg_ + (size_t)(r0 - bg * 2048) * 1024; gate = modl + (size_t)16 * 3072 + 2048; }
        const int row0 = wr * 64 + fr, col0 = u.pn * 256 + wc * 32 + 4 * fq;
        f32x4 gv[2][2];
#pragma unroll
        for (int bj = 0; bj < 2; ++bj)
#pragma unroll
            for (int n = 0; n < 2; ++n) gv[bj][n] = *(const f32x4*)(gate + col0 + bj * HALF + n * 16);
        f32x4 cur[4], nxt[4];
        { const float* rowp = dst + (size_t)row0 * 1024 + col0;
#pragma unroll
          for (int t = 0; t < 4; ++t) cur[t] = __builtin_nontemporal_load((const f32x4*)(rowp + (t >> 1) * HALF + (t & 1) * 16)); }
#pragma unroll
        for (int gi = 0; gi < 8; ++gi) { const int ai = gi >> 2, m = gi & 3;
            if (gi + 1 < 8) { const int ai2 = (gi + 1) >> 2, m2 = (gi + 1) & 3; const float* rp2 = dst + (size_t)(row0 + ai2 * HALF + m2 * 16) * 1024 + col0;
#pragma unroll
                for (int t = 0; t < 4; ++t) nxt[t] = __builtin_nontemporal_load((const f32x4*)(rp2 + (t >> 1) * HALF + (t & 1) * 16)); }
            float* rowp = dst + (size_t)(row0 + ai * HALF + m * 16) * 1024 + col0;
#pragma unroll
            for (int t = 0; t < 4; ++t) __builtin_nontemporal_store(cur[t] + gv[t >> 1][t & 1] * acc[ai][t >> 1][m][t & 1], (f32x4*)(rowp + (t >> 1) * HALF + (t & 1) * 16));
#pragma unroll
            for (int t = 0; t < 4; ++t) cur[t] = nxt[t]; }
    }
};

DI void transpose_cvt(const float* src, u16* dst, int nl, int R, int C, LAS float* tile, int c, int G) {
    const int tid = tidx(), ntr = R / 64, ntc = C / 256, per = ntr * ntc;
    for (int t = c; t < nl * per; t += G) {
        const int l = t / per, rem = t % per, tr = rem / ntc, tc = rem % ntc;
        const float* s = src + ((size_t)l * R + tr * 64) * C + tc * 256;
        u16* d = dst + ((size_t)l * C + tc * 256) * R + tr * 64;
        __syncthreads();
        { const int c4 = (tid & 63) * 4, r0 = tid >> 6;
          f32x4 v[8];
#pragma unroll
          for (int i = 0; i < 8; ++i) v[i] = *(const f32x4*)(s + (size_t)(r0 + 8 * i) * C + c4);
#pragma unroll
          for (int i = 0; i < 8; ++i) { LAS float* tp = tile + (r0 + 8 * i) * 257 + c4; tp[0] = v[i][0]; tp[1] = v[i][1]; tp[2] = v[i][2]; tp[3] = v[i][3]; } }
        __syncthreads();
        { const int rg = (tid & 7) * 8, oc0 = tid >> 3;
#pragma unroll
          for (int i = 0; i < 4; ++i) { const int oc = oc0 + 64 * i; float v[8];
#pragma unroll
              for (int e = 0; e < 8; ++e) v[e] = tile[(rg + e) * 257 + oc];
              u32x4 w; w.x = cvt_pk_bf16(v[0], v[1]); w.y = cvt_pk_bf16(v[2], v[3]); w.z = cvt_pk_bf16(v[4], v[5]); w.w = cvt_pk_bf16(v[6], v[7]);
              *(u32x4*)(d + (size_t)oc * R + rg) = w; } }
    }
}

__device__ __forceinline__ void phase_p0a(const P& p, LAS unsigned char* lds) {
    const int tid = tidx(), c = blockIdx.x, G = gridDim.x;
    const size_t gtid = (size_t)c * NT + tid, gsz = (size_t)G * NT;
    for (int it = c; it < 192; it += G) {
        const int l = it / 48, kp = (it / 6) % 8, nc = it % 6;
        LAS float* sc = (LAS float*)lds;
        __syncthreads();
        for (int i = tid; i < 17 * 128; i += NT) { const int r = i >> 7, k = i & 127; const float v = r < 16 ? p.c[r * 1024 + kp * 128 + k] : p.c_ctx[kp * 128 + k]; sc[i] = silu(v); }
        __syncthreads();
        const int n = nc * 512 + tid;
        float acc[17];
#pragma unroll
        for (int r = 0; r < 17; ++r) acc[r] = 0.f;
        const float* w = p.w_ada + ((size_t)l * 1024 + kp * 128) * 3072 + n;
        for (int k = 0; k < 128; ++k) { const float wv = w[(size_t)k * 3072];
#pragma unroll
            for (int r = 0; r < 17; ++r) acc[r] += sc[r * 128 + k] * wv; }
        float* mp = (float*)(p.ws + p.oModPart) + (((size_t)l * 8 + kp) * 17) * 3072 + n;
#pragma unroll
        for (int r = 0; r < 17; ++r) mp[(size_t)r * 3072] = acc[r];
    }
    __syncthreads();
    transpose_cvt(p.w_in, (u16*)(p.ws + p.oWinT), DEPTH, 1024, NIN, (LAS float*)lds, c, G);
    transpose_cvt(p.w_out, (u16*)(p.ws + p.oWoutT), DEPTH, 2048, 1024, (LAS float*)lds, c, G);
    __syncthreads();
    { u16* Wu = (u16*)(p.ws + p.oWu);
      for (size_t i = gtid; i < (size_t)DEPTH * 1024 * 128; i += gsz) { const size_t lk = i >> 7; const int c8 = (int)(i & 127) * 8; const float* s = p.w_in + lk * NIN + 5120 + c8;
          const f32x4 a = *(const f32x4*)s, b = *(const f32x4*)(s + 4); u32x4 w; w.x = cvt_pk_bf16(a[0], a[1]); w.y = cvt_pk_bf16(a[2], a[3]); w.z = cvt_pk_bf16(b[0], b[1]); w.w = cvt_pk_bf16(b[2], b[3]);
          *(u32x4*)(Wu + lk * 1024 + c8) = w; } }
    { LAS float* ct = (LAS float*)lds; for (int i = tid; i < 256; i += NT) ct[i] = cospif((float)i / 128.f);
      __syncthreads();
      u16* Wc = (u16*)(p.ws + p.oWcsT);
      for (size_t o = gtid; o < (size_t)16 * 32 * 512; o += gsz) { const int j = (int)(o & 511), c8 = (int)((o >> 9) & 31) * 8, lg = (int)(o >> 14);
          const float* W = p.w_four + (size_t)lg * 65536 + (j & 255); const int ph = (j < 256) ? 0 : 192; float a[8];
#pragma unroll
          for (int e = 0; e < 8; ++e) a[e] = 0.f;
#pragma unroll 4
          for (int cp = 0; cp < 256; ++cp) { const float wv = W[(size_t)cp * 256];
#pragma unroll
              for (int e = 0; e < 8; ++e) a[e] += ct[((c8 + e) * cp + ph) & 255] * wv; }
          u32x4 w; w.x = cvt_pk_bf16(a[0], a[1]); w.y = cvt_pk_bf16(a[2], a[3]); w.z = cvt_pk_bf16(a[4], a[5]); w.w = cvt_pk_bf16(a[6], a[7]);
          *(u32x4*)(Wc + ((size_t)lg * 512 + j) * 256 + c8) = w; }
      __syncthreads(); }
    { u16* Dx = (u16*)(p.ws + p.oDx);
      for (size_t o = gtid; o < (size_t)2048 * 2048 / 8; o += gsz) { const int lp = (int)(o >> 8), k8 = (int)(o & 255) * 8; float v[8];
#pragma unroll
          for (int e = 0; e < 8; ++e) { const int kk = k8 + e; const int idx = (lp * (kk & 1023)) & 2047; const float a = (float)idx / 1024.f; v[e] = kk < 1024 ? cospif(a) : -sinpif(a); }
          u32x4 w; w.x = cvt_pk_bf16(v[0], v[1]); w.y = cvt_pk_bf16(v[2], v[3]); w.z = cvt_pk_bf16(v[4], v[5]); w.w = cvt_pk_bf16(v[6], v[7]);
          *(u32x4*)(Dx + o * 8) = w; }
      u16* Dc = (u16*)(p.ws + p.oDc);
      for (size_t o = gtid; o < (size_t)256 * 512 / 8; o += gsz) { const int lp = (int)(o >> 6), k8 = (int)(o & 63) * 8; float v[8];
#pragma unroll
          for (int e = 0; e < 8; ++e) { const int kk = k8 + e; const int idx = (lp * (kk & 255)) & 255; const float a = (float)idx / 128.f; v[e] = kk < 256 ? cospif(a) : -sinpif(a); }
          u32x4 w; w.x = cvt_pk_bf16(v[0], v[1]); w.y = cvt_pk_bf16(v[2], v[3]); w.z = cvt_pk_bf16(v[4], v[5]); w.w = cvt_pk_bf16(v[6], v[7]);
          *(u32x4*)(Dc + o * 8) = w; } }
    { float* pos = (float*)(p.ws + p.oPos);
      for (size_t o = gtid; o < (size_t)2048 * 1024; o += gsz) { const int t = (int)(o >> 10), d = (int)(o & 1023), i = d & 255;
          const float omega = exp2f(-(float)i * (13.287712379549449f / 256.f)); const float pp = (float)(d < 512 ? (t >> 6) : (t & 63)); const float ang = pp * omega;
          pos[o] = ((d >> 8) & 1) ? cosf(ang) : sinf(ang); } }
    { float* lbs = (float*)(p.ws + p.oLbs);
      for (size_t o = gtid; o < 2048; o += gsz) { const int dir = (int)(o >> 10), ch = (int)(o & 1023); float v[4], mx = -1e30f;
#pragma unroll
          for (int l = 0; l < 4; ++l) { v[l] = p.lower[(dir * 4 + l) * 1024 + ch]; mx = fmaxf(mx, v[l]); }
          float s = 0.f;
#pragma unroll
          for (int l = 0; l < 4; ++l) { v[l] = expf(v[l] - mx); s += v[l]; }
          float cum = 0.f; lbs[(dir * 4 + 0) * 1024 + ch] = 0.f;
#pragma unroll
          for (int l = 1; l < 4; ++l) { cum += v[l] / s; lbs[(dir * 4 + l) * 1024 + ch] = cum; } } }
}

__device__ __forceinline__ void phase_p0b(const P& p, LAS unsigned char* lds) {
    const int tid = tidx(), c = blockIdx.x, G = gridDim.x;
    const size_t gtid = (size_t)c * NT + tid, gsz = (size_t)G * NT;
    {
        for (int l = 0; l < DEPTH; ++l) {
            Gemm g; g.A = (const u16*)(p.ws + p.oWcsT) + (size_t)l * 4 * 512 * 256; g.Bt = (const u16*)(p.ws + p.oWu) + (size_t)l * 1024 * 1024; g.lda = 256; g.ldb = 1024; g.K = 256;
            Sched S; S.nM = 2; S.nN = 4; S.nB = 4; S.nw = G / 4; S.wi = ((c / (G / 4)) == l) ? (c % (G / 4)) : (1 << 20); S.mode = 1;     S.aTile = 256L * 256 * 2; S.bTile = 256L * 1024 * 2; S.aBatch = 512L * 256 * 2; S.bBatch = 256L * 2; S.segmap = 0;
            EpiBf E; E.O = (u16*)(p.ws + p.oWpT) + (size_t)l * 2048 * 1024; E.ld = 1024; E.batchStride = 512L * 1024;
            pg8::gemm_phase<EpiBf>(lds, g, S, E);
        }
    }
    { float* mod = (float*)(p.ws + p.oMod); const float* mp = (const float*)(p.ws + p.oModPart);
      for (size_t o = gtid; o < (size_t)DEPTH * 17 * 3072; o += gsz) { const int n = (int)(o % 3072), r = (int)(o / 3072) % 17, l = (int)(o / (3072 * 17)); float s = p.b_ada[l * 3072 + n];
#pragma unroll
          for (int kp = 0; kp < 8; ++kp) s += mp[(((size_t)l * 8 + kp) * 17 + r) * 3072 + n];
          mod[o] = s; } }
    { const float* pos = (const float*)(p.ws + p.oPos);
      const size_t nq = (size_t)NB * SEQ * DM / 4;
      size_t o = gtid;
      for (; o + 3 * gsz < nq; o += 4 * gsz) { f32x4 xv[4], pv[4];
#pragma unroll
          for (int u = 0; u < 4; ++u) { const size_t e = (o + u * gsz) * 4; xv[u] = *(const f32x4*)(p.x + e); pv[u] = *(const f32x4*)(pos + (e & ((size_t)SEQ * DM - 1))); }
#pragma unroll
          for (int u = 0; u < 4; ++u) *(f32x4*)(p.out + (o + u * gsz) * 4) = xv[u] + pv[u]; }
      for (; o < nq; o += gsz) { const size_t e = o * 4; *(f32x4*)(p.out + e) = *(const f32x4*)(p.x + e) + *(const f32x4*)(pos + (e & ((size_t)SEQ * DM - 1))); }
      float* cc = (float*)(p.ws + p.oCtx);
      for (size_t o = gtid; o < (size_t)NB * CTXL * DM / 4; o += gsz) *(f32x4*)(cc + o * 4) = *(const f32x4*)(p.ctx + o * 4); }
}

#define XB_TMO      128
#define XB_XCNT(j)  (256  + 64 * (j))
#define XB_XSUB(j)  (1280 + 64 * (j))
#define XB_XGEN(j)  (2304 + 64 * (j))
#define XB_TOP      3328
#define XB_TOPGEN   3392
#define XCD_BAR_WORDS 3456
#define XB_SPIN_CAP (1u << 18)
DI unsigned xb_ld(unsigned* p)              { return __hip_atomic_load(p, __ATOMIC_RELAXED, __HIP_MEMORY_SCOPE_AGENT); }
DI unsigned xb_add(unsigned* p, unsigned v) { return __hip_atomic_fetch_add(p, v, __ATOMIC_RELAXED, __HIP_MEMORY_SCOPE_AGENT); }
DI unsigned xb_xcc_id() { return (unsigned)__builtin_amdgcn_s_getreg((3 << 11) | 20) & 0xFu; }
#define XB_SPIN(cond, bar) do { unsigned _sp = 0; while (cond) { __builtin_amdgcn_s_sleep(1); \
    if ((++_sp & 255u) == 0u) { if (xb_ld(&(bar)[XB_TMO])) break; if (_sp > XB_SPIN_CAP) { atomicAdd(&(bar)[XB_TMO], 1u); break; } } } } while (0)
DI void xcd_barrier_post(unsigned* bar) { if (threadIdx.x == 0) (void)xb_add(&bar[XB_XCNT(xb_xcc_id())], 1u); }
DI void xcd_barrier_complete(unsigned* bar, unsigned x, unsigned& nloc, unsigned& nx) {
    const unsigned G = gridDim.x;
    unsigned sum, cnt, mine, sp = 0u;
    for (;;) {
        sum = 0u; cnt = 0u; mine = 0u;
#pragma unroll
        for (unsigned j = 0; j < 16; ++j) { const unsigned c = xb_ld(&bar[XB_XCNT(j)]); sum += c; cnt += (c > 0u) ? 1u : 0u; mine = (j == x) ? c : mine; }
        if (sum == G) break;
        __builtin_amdgcn_s_sleep(1);
        if ((++sp & 255u) == 0u) { if (xb_ld(&bar[XB_TMO])) break; if (sp > XB_SPIN_CAP) { atomicAdd(&bar[XB_TMO], 1u); break; } }
    }
    nloc = mine > 0u ? mine : 1u; nx = cnt > 0u ? cnt : 1u;
}
DI void xcd_barrier(unsigned* bar, volatile LAS unsigned* st) {
    asm volatile("s_waitcnt vmcnt(0)" ::: "memory");
    __syncthreads();
    if (threadIdx.x == 0) {
        const unsigned x = xb_xcc_id();
        __builtin_amdgcn_s_waitcnt(0);
        unsigned nloc = st[0], nx = st[1];
        if (nloc == 0u) { xcd_barrier_complete(bar, x, nloc, nx); st[0] = nloc; st[1] = nx; }
        const unsigned old = xb_add(&bar[XB_XSUB(x)], 1u);
        const unsigned gen = old / nloc;
        if (old + 1u == (gen + 1u) * nloc) {
            __builtin_amdgcn_fence(__ATOMIC_RELEASE, "agent");
            asm volatile("s_waitcnt vmcnt(0)" ::: "memory");
            const unsigned og = xb_add(&bar[XB_TOP], 1u);
            const unsigned tg = og / nx;
            if (og + 1u == (tg + 1u) * nx) xb_add(&bar[XB_TOPGEN], 1u);
            else XB_SPIN(xb_ld(&bar[XB_TOPGEN]) == tg, bar);
            __builtin_amdgcn_fence(__ATOMIC_ACQUIRE, "agent");
            xb_add(&bar[XB_XGEN(x)], 1u);
            asm volatile("s_waitcnt vmcnt(0)" ::: "memory");
        } else {
            XB_SPIN(xb_ld(&bar[XB_XGEN(x)]) == gen, bar);
            __builtin_amdgcn_fence(__ATOMIC_ACQUIRE, "agent");
            asm volatile("s_waitcnt vmcnt(0)" ::: "memory");
        }
    }
    __syncthreads();
}


DI void store_row(u16* dst, int lane, const f32x4 (&y)[4]) {
#pragma unroll
    for (int i = 0; i < 4; ++i) { u32x2 o; o.x = cvt_pk_bf16(y[i][0], y[i][1]); o.y = cvt_pk_bf16(y[i][2], y[i][3]); __builtin_nontemporal_store(o, (u32x2*)(dst + i * 256 + lane * 4)); }
}
__device__ __forceinline__ void phase_norm(const P& p, int l, int grp, int c, int G) {
    const int tid = tidx(), lane = tid & 63, w = tid >> 6, bg = p.bg;
    const float* modl = (const float*)(p.ws + p.oMod) + (size_t)l * 17 * 3072;
    const float* nw = p.norm_w + l * 1024;
    u16* H = (u16*)(p.ws + p.oH); u16* H2 = (u16*)(p.ws + p.oH2);
    const int nitems = bg * (1025 + 256);
    auto rows_of = [&](int it, const float*& pa, const float*& pb) {
        if (it < bg * 1025) { const int bl = it / 1025, li = it % 1025; const float* xb = p.out + ((size_t)(grp * bg + bl) * 2048) * 1024;
            pa = xb + (size_t)li * 1024; pb = (li > 0 && li < 1024) ? xb + (size_t)(2048 - li) * 1024 : pa; }
        else { pa = (const float*)(p.ws + p.oCtx) + ((size_t)grp * bg * 256 + (it - bg * 1025)) * 1024; pb = pa; } };
    f32x4 wv[4];
#pragma unroll
    for (int i = 0; i < 4; ++i) wv[i] = *(const f32x4*)(nw + i * 256 + lane * 4);
    f32x4 va[4], vb[4], na[4], nb[4];
    int it = c * 8 + w;
    if (it < nitems) { const float *pa, *pb; rows_of(it, pa, pb);
#pragma unroll
        for (int i = 0; i < 4; ++i) { va[i] = __builtin_nontemporal_load((const f32x4*)(pa + i * 256 + lane * 4)); vb[i] = __builtin_nontemporal_load((const f32x4*)(pb + i * 256 + lane * 4)); } }
    for (; it < nitems; it += G * 8) {
        const int nit = it + G * 8;
        if (nit < nitems) { const float *pa, *pb; rows_of(nit, pa, pb);
#pragma unroll
            for (int i = 0; i < 4; ++i) { na[i] = __builtin_nontemporal_load((const f32x4*)(pa + i * 256 + lane * 4)); nb[i] = __builtin_nontemporal_load((const f32x4*)(pb + i * 256 + lane * 4)); } }
        const bool isx = it < bg * 1025; const int bl = isx ? it / 1025 : 0, li = isx ? it % 1025 : 0;
        const float* md = modl + (size_t)(isx ? grp * bg + bl : 16) * 3072;
        float sa = 0.f, sb = 0.f;
#pragma unroll
        for (int i = 0; i < 4; ++i) { sa += va[i][0] * va[i][0] + va[i][1] * va[i][1] + va[i][2] * va[i][2] + va[i][3] * va[i][3]; sb += vb[i][0] * vb[i][0] + vb[i][1] * vb[i][1] + vb[i][2] * vb[i][2] + vb[i][3] * vb[i][3]; }
#pragma unroll
        for (int o = 32; o >= 1; o >>= 1) { sa += __shfl_xor(sa, o); sb += __shfl_xor(sb, o); }
        const float ra = rsqrtf(sa * (1.f / 1024.f) + 1e-6f), rb = rsqrtf(sb * (1.f / 1024.f) + 1e-6f);
        f32x4 y1[4], y2[4];
#pragma unroll
        for (int i = 0; i < 4; ++i) { const int col = i * 256 + lane * 4; const f32x4 sh = *(const f32x4*)(md + col), scl = *(const f32x4*)(md + 1024 + col) + 1.f;
            y1[i] = va[i] * ra * wv[i] * scl + sh; y2[i] = vb[i] * rb * wv[i] * scl + sh; }
        if (isx) {
            u16* Hb = H + (size_t)bl * 2048 * 1024; u16* H2b = H2 + (size_t)bl * 2048 * 1024;
            store_row(Hb + (size_t)li * 1024, lane, y1);
            if (li == 0) { store_row(H2b, lane, y1);
#pragma unroll
                for (int i = 0; i < 4; ++i) y2[i] = (f32x4){0.f, 0.f, 0.f, 0.f};
                store_row(H2b + (size_t)1024 * 1024, lane, y2); }
            else if (li < 1024) { store_row(Hb + (size_t)(2048 - li) * 1024, lane, y2);
                f32x4 e[4], o[4];
#pragma unroll
                for (int i = 0; i < 4; ++i) { e[i] = y1[i] + y2[i]; o[i] = y1[i] - y2[i]; }
                store_row(H2b + (size_t)li * 1024, lane, e); store_row(H2b + (size_t)(1024 + li) * 1024, lane, o); }
        } else {
            const int r = it - bg * 1025;
            store_row(H + ((size_t)bg * 2048 + r) * 1024, lane, y1); store_row(H2 + ((size_t)bg * 2048 + r) * 1024, lane, y1);
        }
#pragma unroll
        for (int i = 0; i < 4; ++i) { va[i] = na[i]; vb[i] = nb[i]; }
    }
}

__device__ __forceinline__ void phase_gemm_in(const P& p, int l, LAS unsigned char* lds) {
    const int c = blockIdx.x, G = gridDim.x, bg = p.bg; const int nMt = bg * 9;
    { const int tid = tidx(), lane = tid & 63, w = tid >> 6; const u16* Wp = (const u16*)(p.ws + p.oWpT) + (size_t)l * 2048 * 1024; const u16* H = (const u16*)(p.ws + p.oH); float* T = (float*)(p.ws + p.oT1024);
      for (int o0 = c * 8 + w; o0 < bg * 1024; o0 += 4 * G * 8) { u32x4 av[4][2], bv[4][2];
#pragma unroll
          for (int u = 0; u < 4; ++u) { const int o = o0 + u * G * 8; const int oo = o < bg * 1024 ? o : o0; const int bl = oo >> 10, j = oo & 1023, g = j >> 8, n = j & 255;
              const u16* a = Wp + (size_t)(g * 512 + n) * 1024 + lane * 16; const u16* b = H + ((size_t)bl * 2048 + 1024) * 1024 + lane * 16;
              av[u][0] = *(const u32x4*)a; av[u][1] = *(const u32x4*)(a + 8); bv[u][0] = *(const u32x4*)b; bv[u][1] = *(const u32x4*)(b + 8); }
          float sacc[4];
#pragma unroll
          for (int u = 0; u < 4; ++u) { sacc[u] = 0.f;
#pragma unroll
              for (int hh = 0; hh < 2; ++hh)
#pragma unroll
                  for (int e = 0; e < 4; ++e) sacc[u] += bflo(av[u][hh][e]) * bflo(bv[u][hh][e]) + bfhi(av[u][hh][e]) * bfhi(bv[u][hh][e]); }
#pragma unroll
          for (int m = 32; m >= 1; m >>= 1) {
#pragma unroll
              for (int u = 0; u < 4; ++u) sacc[u] += __shfl_xor(sacc[u], m); }
#pragma unroll
          for (int u = 0; u < 4; ++u) { const int o = o0 + u * G * 8; if (lane == 0 && o < bg * 1024) T[o] = sacc[u]; } } }
    const int u1 = nMt * 20, u2 = 40 * bg;
    { Gemm g; g.A = (const u16*)(p.ws + p.oH); g.Bt = (const u16*)(p.ws + p.oWinT) + (size_t)l * NIN * 1024; g.lda = 1024; g.ldb = 1024; g.K = 1024;
      Sched S; S.nM = nMt; S.nN = 20; S.nB = 1; S.nw = G; S.wi = c; S.mode = 0; S.aTile = 256L * 1024 * 2; S.bTile = 256L * 1024 * 2; S.aBatch = 0; S.bBatch = 0; S.segmap = 1;
      EpiIn E; E.V = (u16*)(p.ws + p.oV); E.ZF = (u16*)(p.ws + p.oZF); E.ZB = (u16*)(p.ws + p.oZB); E.Q = (u16*)(p.ws + p.oQ); E.G2 = (u16*)(p.ws + p.oG2); E.forced = -1; E.rowbase = 0; E.lbl = (const float*)(p.ws + p.oLbs) + l * 1024;
      pg8::gemm_phase<EpiIn>(lds, g, S, E); }
    { Gemm g; g.A = (const u16*)(p.ws + p.oWpT) + (size_t)l * 2048 * 1024; g.Bt = (const u16*)(p.ws + p.oH2); g.lda = 1024; g.ldb = 1024; g.K = 1024;
      Sched S; S.nM = 8; S.nN = nMt; S.nB = bg; S.nw = G; S.wi = (c + G - u1 % G) % G; S.mode = 2; S.aTile = 256L * 1024 * 2; S.bTile = 256L * 1024 * 2; S.aBatch = 0; S.bBatch = 0; S.segmap = 0;
      EpiTt E; E.Ttx = (u16*)(p.ws + p.oTtx); E.Ttc = (u16*)(p.ws + p.oTtc); E.bg = bg;
      pg8::gemm_phase<EpiTt>(lds, g, S, E); }
    { Gemm g; g.A = (const u16*)(p.ws + p.oH) + (size_t)bg * 2048 * 1024; g.Bt = (const u16*)(p.ws + p.oWinT) + (size_t)l * NIN * 1024; g.lda = 1024; g.ldb = 1024; g.K = 1024;
      Sched S; S.nM = bg; S.nN = 4; S.nB = 1; S.nw = G; S.wi = (c + 2 * G - (u1 + u2) % G) % G; S.mode = 0; S.aTile = 256L * 1024 * 2; S.bTile = 256L * 1024 * 2; S.aBatch = 0; S.bBatch = 0; S.segmap = 2;
      EpiIn E; E.V = (u16*)(p.ws + p.oV); E.ZF = (u16*)(p.ws + p.oZF); E.ZB = (u16*)(p.ws + p.oZB); E.Q = (u16*)(p.ws + p.oQ); E.G2 = (u16*)(p.ws + p.oG2); E.forced = 4; E.rowbase = bg * 2048; E.lbl = (const float*)(p.ws + p.oLbs) + l * 1024;
      pg8::gemm_phase<EpiIn>(lds, g, S, E); }
}

__device__ __forceinline__ void scan_chain(const P& p, int l, int ci, LAS unsigned char* lds) {
    const int tid = tidx(), lane = tid & 63, w = __builtin_amdgcn_readfirstlane(tid >> 6), r = lane & 15, q = lane >> 4;
    const int bg = p.bg;
    const int bl = ci >> 4, dir = (ci >> 3) & 1, h = ci & 7;
    const u16* Vg = (const u16*)(p.ws + p.oV) + h * 128;
    const u16* Qg = (const u16*)(p.ws + p.oQ) + h * 128;
    u16* Zg = (u16*)(p.ws + (dir ? p.oZB : p.oZF)) + h * 128;
    constexpr int PB = 45568;
    const bool prepw = w >= 4; const int pw = w & 3, tg = q;
    const int dchA = 16 * pw + r, dchB = 64 + dchA;
    const int swA = (dchA * 2) ^ (tg << 5), swB = (dchB * 2) ^ (tg << 5);
    const float* lbp = (const float*)(p.ws + p.oLbs) + (dir * 4 + l) * 1024 + h * 128;
    const float omlA = 1.f - lbp[dchA], omlB = 1.f - lbp[dchB];
    const int pt = pw * 64 + lane, tokv = pt >> 4, cg8 = (pt & 15) * 8;
    f32x4 S0[8], S1[8];
#pragma unroll
    for (int i = 0; i < 8; ++i) { S0[i] = (f32x4){0.f, 0.f, 0.f, 0.f}; S1[i] = S0[i]; }
    auto rowof = [&](int cc, int t) -> int { const int part = cc >= 8, cidx = part ? cc - 8 : cc, pos = cidx * 32 + t, Lp = part ? 2048 : 256, base = part ? bl * 2048 : bg * 2048 + bl * 256;
        return base + (dir ? Lp - 1 - pos : pos); };
    u16 zcA[8], qcA[8], zcB[8], qcB[8], znA[8], qnA[8], znB[8], qnB[8]; u32x4 vc0, vc1, vn0, vn1;
#define SC_BAR() asm volatile("s_waitcnt lgkmcnt(0)\n\ts_barrier" ::: "memory")
    const long rstr = dir ? -1024 : 1024;
#define SC_LOAD(cc, ZA_, QA_, ZB_, QB_, V0_, V1_) do { const size_t ro = (size_t)rowof(cc, 8 * tg) * 1024; const u16* zp_ = Zg + ro; const u16* qp_ = Qg + ro; \
        _Pragma("unroll") for (int i = 0; i < 8; ++i) { ZA_[i] = zp_[i * rstr + dchA]; QA_[i] = qp_[i * rstr + dchA]; ZB_[i] = zp_[i * rstr + dchB]; QB_[i] = qp_[i * rstr + dchB]; } \
        const u16* vp_ = Vg + (size_t)rowof(cc, tokv) * 1024 + cg8; V0_ = *(const u32x4*)vp_; V1_ = *(const u32x4*)(vp_ + 16 * rstr); } while (0)
#define SC_PREP1(B_, Z_, Q_, dch, swc, oml) do { LAS float* E_ = (LAS float*)(B_ + 36352); float pr[8], k8[8]; \
        _Pragma("unroll") for (int i = 0; i < 8; ++i) { const float k = h2f(Z_[i]); k8[i] = k; pr[i] = fmaxf(1.f - k, 1e-6f); } \
        _Pragma("unroll") for (int i = 1; i < 8; ++i) pr[i] *= pr[i - 1]; \
        const float t0 = __shfl(pr[7], r), t1 = __shfl(pr[7], 16 + r), t2 = __shfl(pr[7], 32 + r), t3 = __shfl(pr[7], 48 + r); \
        const float er = fmaxf(t0 * t1, 1e-32f), eer = t2 * t3; \
          \
        const float sc = tg == 0 ? __builtin_amdgcn_rcpf(er) : (tg == 1 ? __builtin_amdgcn_rcpf(fmaxf(t1, 1e-32f)) : (tg == 2 ? 1.f : t2)); \
        if (tg == 3) E_[dch] = er * eer; \
        const float sc2 = tg == 0 ? 1.f : (tg == 1 ? t0 : (tg == 2 ? er : er * t2)); \
        unsigned kt[4]; \
        _Pragma("unroll") for (int i = 0; i < 8; i += 2) { const float r0 = fminf(fmaxf(sc * pr[i], 1e-32f), 1e32f), r1 = fminf(fmaxf(sc * pr[i + 1], 1e-32f), 1e32f); \
            const float qf0 = bf2f(Q_[i]), qf1 = bf2f(Q_[i + 1]); \
            const unsigned qq = cvt_pk_bf16(qf0 * r0, qf1 * r1); \
            const unsigned qh = cvt_pk_bf16(qf0 * (sc2 * pr[i]), qf1 * (sc2 * pr[i + 1])); \
            *(LAS u16*)(B_ + 36864 + (8 * tg + i) * 272 + swc) = (u16)(qh & 0xffffu); *(LAS u16*)(B_ + 36864 + (8 * tg + i + 1) * 272 + swc) = (u16)(qh >> 16); \
            *(LAS u16*)(B_ + (8 * tg + i) * 272 + swc) = (u16)(qq & 0xffffu); *(LAS u16*)(B_ + (8 * tg + i + 1) * 272 + swc) = (u16)(qq >> 16); \
            const unsigned kk = cvt_pk_bf16(k8[i] * __builtin_amdgcn_rcpf(r0), k8[i + 1] * __builtin_amdgcn_rcpf(r1)); \
            *(LAS u16*)(B_ + 8704 + (8 * tg + i) * 272 + swc) = (u16)(kk & 0xffffu); *(LAS u16*)(B_ + 8704 + (8 * tg + i + 1) * 272 + swc) = (u16)(kk >> 16); \
            kt[i >> 1] = cvt_pk_bf16(k8[i] * __builtin_amdgcn_rcpf(r0) * eer, k8[i + 1] * __builtin_amdgcn_rcpf(r1) * eer); } \
        *(LAS u32x4*)(B_ + 17408 + dch * 80 + tg * 16) = (u32x4){kt[0], kt[1], kt[2], kt[3]}; } while (0)
#define SC_PREP(par_, ZA_, QA_, ZB_, QB_, V0_, V1_) do { LAS unsigned char* Bp_ = lds + (par_) * PB; \
        SC_PREP1(Bp_, ZA_, QA_, dchA, swA, omlA); SC_PREP1(Bp_, ZB_, QB_, dchB, swB, omlB); \
        *(LAS u32x4*)(Bp_ + 27648 + tokv * 272 + cg8 * 2) = V0_; *(LAS u32x4*)(Bp_ + 27648 + (16 + tokv) * 272 + cg8 * 2) = V1_; } while (0)
    auto mfma_stage = [&](const int cc, const int par) {
        const LAS unsigned char* Qp = lds + par * PB; const LAS unsigned char* Kn = Qp + 8704; const LAS unsigned char* Kt = Qp + 17408; const LAS unsigned char* Vp = Qp + 27648;
        const LAS float* Eend = (const LAS float*)(Qp + 36352); const LAS unsigned char* Qh = Qp + 36864;
        const int sx0 = (r >> 3) << 5, sx1 = (2 + (r >> 3)) << 5;
        const int dv0 = 32 * pw + r, dv1 = dv0 + 16;
        f32x4 P00 = {0.f, 0.f, 0.f, 0.f}, P01 = P00, P11 = P00;
#pragma unroll
        for (int ks = 0; ks < 4; ++ks) {
            const int c0 = (ks * 64 + q * 16) ^ sx0, c1 = (ks * 64 + q * 16) ^ sx1;
            const bf16x8 a0 = *(const LAS bf16x8*)(Kn + r * 272 + c0), a1 = *(const LAS bf16x8*)(Kn + (16 + r) * 272 + c1);
            const bf16x8 b0 = *(const LAS bf16x8*)(Qp + r * 272 + c0), b1 = *(const LAS bf16x8*)(Qp + (16 + r) * 272 + c1);
            P00 = __builtin_amdgcn_mfma_f32_16x16x32_bf16(a0, b0, P00, 0, 0, 0);
            P01 = __builtin_amdgcn_mfma_f32_16x16x32_bf16(a0, b1, P01, 0, 0, 0);
            P11 = __builtin_amdgcn_mfma_f32_16x16x32_bf16(a1, b1, P11, 0, 0, 0); }
#pragma unroll
        for (int j = 0; j < 4; ++j) { if (4 * q + j > r) { P00[j] = 0.f; P11[j] = 0.f; } }
        u32x4 bp0, bp1;
        bp0.x = cvt_pk_bf16(P00[0], P00[1]); bp0.y = cvt_pk_bf16(P00[2], P00[3]); bp0.z = 0u; bp0.w = 0u;
        bp1.x = cvt_pk_bf16(P01[0], P01[1]); bp1.y = cvt_pk_bf16(P01[2], P01[3]); bp1.z = cvt_pk_bf16(P11[0], P11[1]); bp1.w = cvt_pk_bf16(P11[2], P11[3]);
        f32x4 O00 = {0.f, 0.f, 0.f, 0.f}, O01 = O00, O10 = O00, O11 = O00;
#pragma unroll
        for (int ks = 0; ks < 4; ++ks) {
            u32x4 a, a2;
            a.x = cvt_pk_bf16(S0[2 * ks][0], S0[2 * ks][1]); a.y = cvt_pk_bf16(S0[2 * ks][2], S0[2 * ks][3]); a.z = cvt_pk_bf16(S0[2 * ks + 1][0], S0[2 * ks + 1][1]); a.w = cvt_pk_bf16(S0[2 * ks + 1][2], S0[2 * ks + 1][3]);
            a2.x = cvt_pk_bf16(S1[2 * ks][0], S1[2 * ks][1]); a2.y = cvt_pk_bf16(S1[2 * ks][2], S1[2 * ks][3]); a2.z = cvt_pk_bf16(S1[2 * ks + 1][0], S1[2 * ks + 1][1]); a2.w = cvt_pk_bf16(S1[2 * ks + 1][2], S1[2 * ks + 1][3]);
            const u32x2 l0 = *(const LAS u32x2*)(Qh + r * 272 + (((32 * ks + 4 * q) * 2) ^ sx0)), h0 = *(const LAS u32x2*)(Qh + r * 272 + (((32 * ks + 16 + 4 * q) * 2) ^ sx0));
            const u32x2 l1 = *(const LAS u32x2*)(Qh + (16 + r) * 272 + (((32 * ks + 4 * q) * 2) ^ sx1)), h1 = *(const LAS u32x2*)(Qh + (16 + r) * 272 + (((32 * ks + 16 + 4 * q) * 2) ^ sx1));
            const u32x4 b0 = {l0.x, l0.y, h0.x, h0.y}, b1 = {l1.x, l1.y, h1.x, h1.y};
            O00 = __builtin_amdgcn_mfma_f32_16x16x32_bf16(__builtin_bit_cast(bf16x8, a), __builtin_bit_cast(bf16x8, b0), O00, 0, 0, 0);
            O01 = __builtin_amdgcn_mfma_f32_16x16x32_bf16(__builtin_bit_cast(bf16x8, a), __builtin_bit_cast(bf16x8, b1), O01, 0, 0, 0);
            O10 = __builtin_amdgcn_mfma_f32_16x16x32_bf16(__builtin_bit_cast(bf16x8, a2), __builtin_bit_cast(bf16x8, b0), O10, 0, 0, 0);
            O11 = __builtin_amdgcn_mfma_f32_16x16x32_bf16(__builtin_bit_cast(bf16x8, a2), __builtin_bit_cast(bf16x8, b1), O11, 0, 0, 0); }
        bf16x8 av0, av1, bv0, bv1;
#pragma unroll
        for (int j8 = 0; j8 < 8; ++j8) { const int sv = 16 * (j8 >> 2) + 4 * q + (j8 & 3);
            av0[j8] = (short)*(const LAS u16*)(Vp + sv * 272 + dv0 * 2); av1[j8] = (short)*(const LAS u16*)(Vp + sv * 272 + dv1 * 2);
            bv0[j8] = (short)*(const LAS u16*)(Vp + (8 * q + j8) * 272 + dv0 * 2); bv1[j8] = (short)*(const LAS u16*)(Vp + (8 * q + j8) * 272 + dv1 * 2); }
        O00 = __builtin_amdgcn_mfma_f32_16x16x32_bf16(av0, __builtin_bit_cast(bf16x8, bp0), O00, 0, 0, 0);
        O01 = __builtin_amdgcn_mfma_f32_16x16x32_bf16(av0, __builtin_bit_cast(bf16x8, bp1), O01, 0, 0, 0);
        O10 = __builtin_amdgcn_mfma_f32_16x16x32_bf16(av1, __builtin_bit_cast(bf16x8, bp0), O10, 0, 0, 0);
        O11 = __builtin_amdgcn_mfma_f32_16x16x32_bf16(av1, __builtin_bit_cast(bf16x8, bp1), O11, 0, 0, 0);
        { u16* op = Zg + (size_t)rowof(cc, r) * 1024 + 32 * pw + 4 * q;
          u32x2 o; o.x = cvt_pk_bf16(O00[0], O00[1]); o.y = cvt_pk_bf16(O00[2], O00[3]); *(u32x2*)op = o;
          o.x = cvt_pk_bf16(O01[0], O01[1]); o.y = cvt_pk_bf16(O01[2], O01[3]); *(u32x2*)(op + 16 * rstr) = o;
          o.x = cvt_pk_bf16(O10[0], O10[1]); o.y = cvt_pk_bf16(O10[2], O10[3]); *(u32x2*)(op + 16) = o;
          o.x = cvt_pk_bf16(O11[0], O11[1]); o.y = cvt_pk_bf16(O11[2], O11[3]); *(u32x2*)(op + 16 * rstr + 16) = o; }
#pragma unroll
        for (int i = 0; i < 8; ++i) { const bf16x8 a = *(const LAS bf16x8*)(Kt + (16 * i + r) * 80 + q * 16);
            const f32x4 e = *(const LAS f32x4*)(Eend + 16 * i + 4 * q);
            S0[i] = __builtin_amdgcn_mfma_f32_16x16x32_bf16(a, bv0, S0[i] * e, 0, 0, 0);
            S1[i] = __builtin_amdgcn_mfma_f32_16x16x32_bf16(a, bv1, S1[i] * e, 0, 0, 0); }
    };
    __syncthreads();
    if (prepw) {
        SC_LOAD(0, zcA, qcA, zcB, qcB, vc0, vc1); SC_PREP(0, zcA, qcA, zcB, qcB, vc0, vc1); SC_LOAD(1, znA, qnA, znB, qnB, vn0, vn1); SC_LOAD(2, zcA, qcA, zcB, qcB, vc0, vc1);
        SC_BAR();
        for (int cc = 0; cc < 72; cc += 2) {
            SC_PREP(1, znA, qnA, znB, qnB, vn0, vn1); if (cc + 3 < 72) SC_LOAD(cc + 3, znA, qnA, znB, qnB, vn0, vn1);
            SC_BAR();
            if (cc + 2 < 72) { SC_PREP(0, zcA, qcA, zcB, qcB, vc0, vc1); if (cc + 4 < 72) SC_LOAD(cc + 4, zcA, qcA, zcB, qcB, vc0, vc1); }
            SC_BAR();
        }
    } else {
        SC_BAR();
        for (int cc = 0; cc < 72; cc += 2) { mfma_stage(cc, 0); SC_BAR(); mfma_stage(cc + 1, 1); SC_BAR(); }
    }
    __syncthreads();
#undef SC_BAR
#undef SC_LOAD
#undef SC_PREP1
#undef SC_PREP
}

__device__ __forceinline__ void phase_scan_f3(const P& p, int l, int grp, LAS unsigned char* lds) {
    const int c = blockIdx.x, G = gridDim.x, bg = p.bg; const int nch = bg * 16;
#if (ONLY & 16)
    for (int ci = c; ci < nch; ci += G) scan_chain(p, l, ci, lds);
#endif
#if (ONLY & 64)
    int nw, wi;
    if (G > nch) { nw = G - nch; wi = c - nch; if (c < nch) return; } else { nw = G; wi = c; }
    { Gemm g; g.A = (const u16*)(p.ws + p.oDx); g.Bt = (const u16*)(p.ws + p.oTtx); g.lda = 2048; g.ldb = 2048; g.K = 2048;
      Sched S; S.nM = 8; S.nN = 1; S.nB = bg * 4; S.nw = nw; S.wi = wi; S.mode = 1; S.aTile = 256L * 2048 * 2; S.bTile = 0; S.aBatch = 0; S.bBatch = 256L * 2048 * 2; S.segmap = 0;
      EpiF3 E; E.G2 = (u16*)(p.ws + p.oG2); E.bias = p.b_four + l * 1024; E.scale = 1.f / sqrtf(2048.f * 256.f); E.rowbase = 0; E.Lp = 2048; E.t1024 = (const float*)(p.ws + p.oT1024);
      pg8::gemm_phase<EpiF3>(lds, g, S, E); }
    if (l < DEPTH - 1) { Gemm g; g.A = (const u16*)(p.ws + p.oDc); g.Bt = (const u16*)(p.ws + p.oTtc); g.lda = 512; g.ldb = 512; g.K = 512;
      Sched S; S.nM = 1; S.nN = 1; S.nB = bg * 4; S.nw = nw; S.wi = (wi + nw / 2) % nw; S.mode = 1; S.aTile = 0; S.bTile = 0; S.aBatch = 0; S.bBatch = 256L * 512 * 2; S.segmap = 0;
      EpiF3 E; E.G2 = (u16*)(p.ws + p.oG2); E.bias = p.b_four + l * 1024; E.scale = 1.f / sqrtf(256.f * 256.f); E.rowbase = bg * 2048; E.Lp = 256; E.t1024 = nullptr;
      pg8::gemm_phase<EpiF3>(lds, g, S, E); }
#endif
    { Gemm g; g.A = (const u16*)(p.ws + p.oH); g.Bt = (const u16*)(p.ws + p.oWinT) + (size_t)l * NIN * 1024; g.lda = 1024; g.ldb = 1024; g.K = 1024;
      Sched S; S.nM = bg * 8; S.nN = 4; S.nB = 1; S.nw = nw; S.wi = wi; S.mode = 0; S.aTile = 256L * 1024 * 2; S.bTile = 256L * 1024 * 2; S.aBatch = 0; S.bBatch = 0; S.segmap = 2;
      EpiIn E; E.V = (u16*)(p.ws + p.oV); E.ZF = (u16*)(p.ws + p.oZF); E.ZB = (u16*)(p.ws + p.oZB); E.Q = (u16*)(p.ws + p.oQ); E.G2 = (u16*)(p.ws + p.oG2); E.forced = 4; E.rowbase = 0; E.lbl = (const float*)(p.ws + p.oLbs) + l * 1024;
      pg8::gemm_phase<EpiIn>(lds, g, S, E); }
    { unsigned* cnt = (unsigned*)(p.ws + p.oBar) + XCD_BAR_WORDS + (l * p.ng + grp) * 64;
      asm volatile("s_waitcnt vmcnt(0) lgkmcnt(0)" ::: "memory"); __syncthreads();
      if (threadIdx.x == 0) { (void)xb_add(cnt, 1u); unsigned sp = 0; while (xb_ld(cnt) < (unsigned)nw) { __builtin_amdgcn_s_sleep(2); if (++sp > (1u << 22)) break; } }
      __syncthreads(); }
    { int nl = l, ngp = grp + 1; if (ngp == p.ng) { ngp = 0; ++nl; }
      if (nl < DEPTH) phase_norm(p, nl, ngp, wi, nw); }
}

__device__ __forceinline__ void phase_combine(const P& p, int l) {
    const int tid = tidx(), c = blockIdx.x, G = gridDim.x, bg = p.bg; const int Mg = (l == DEPTH - 1) ? bg * 2048 : bg * 2304;
    const u16* OF = (const u16*)(p.ws + p.oZF); const u16* OB = (const u16*)(p.ws + p.oZB); u16* G2 = (u16*)(p.ws + p.oG2);
    const int ch = (tid & 127) * 8; const float* hw = p.hn_w + l * 1024 + ch;
    float hv[8];
#pragma unroll
    for (int e = 0; e < 8; ++e) hv[e] = hw[e];
    const int step = G * 4;
    int row = c * 4 + (tid >> 7);
    u32x4 a[2], b[2], gt[2], an[2], bn[2], gn[2];
#pragma unroll
    for (int u = 0; u < 2; ++u) { const int r = row + u * step; if (r < Mg) { a[u] = __builtin_nontemporal_load((const u32x4*)(OF + (size_t)r * 1024 + ch)); b[u] = __builtin_nontemporal_load((const u32x4*)(OB + (size_t)r * 1024 + ch)); gt[u] = __builtin_nontemporal_load((const u32x4*)(G2 + (size_t)r * 2048 + ch)); } }
    for (; row < Mg; row += 2 * step) {
#pragma unroll
        for (int u = 0; u < 2; ++u) { const int r = row + (2 + u) * step; if (r < Mg) { an[u] = __builtin_nontemporal_load((const u32x4*)(OF + (size_t)r * 1024 + ch)); bn[u] = __builtin_nontemporal_load((const u32x4*)(OB + (size_t)r * 1024 + ch)); gn[u] = __builtin_nontemporal_load((const u32x4*)(G2 + (size_t)r * 2048 + ch)); } }
#pragma unroll
        for (int u = 0; u < 2; ++u) { const int r = row + u * step;
            float o[8], gg[8]; float ss = 0.f;
#pragma unroll
            for (int e = 0; e < 4; ++e) { o[2 * e] = bflo(a[u][e]) + bflo(b[u][e]); o[2 * e + 1] = bfhi(a[u][e]) + bfhi(b[u][e]); gg[2 * e] = bflo(gt[u][e]); gg[2 * e + 1] = bfhi(gt[u][e]); }
#pragma unroll
            for (int e = 0; e < 8; ++e) ss += o[e] * o[e];
#pragma unroll
            for (int m = 8; m >= 1; m >>= 1) ss += __shfl_xor(ss, m);
            const float rs = rsqrtf(ss * (1.f / 128.f) + 1e-6f);
            u32x4 wv;
#pragma unroll
            for (int e = 0; e < 4; ++e) wv[e] = cvt_pk_bf16(o[2 * e] * rs * hv[2 * e] * gg[2 * e], o[2 * e + 1] * rs * hv[2 * e + 1] * gg[2 * e + 1]);
            if (r < Mg) *(u32x4*)(G2 + (size_t)r * 2048 + ch) = wv; }
#pragma unroll
        for (int u = 0; u < 2; ++u) { a[u] = an[u]; b[u] = bn[u]; gt[u] = gn[u]; }
    }
}

__device__ __forceinline__ void phase_gemm_out(const P& p, int l, int grp, LAS unsigned char* lds) {
    const int c = blockIdx.x, G = gridDim.x, bg = p.bg;
    Gemm g; g.A = (const u16*)(p.ws + p.oG2); g.Bt = (const u16*)(p.ws + p.oWoutT) + (size_t)l * 1024 * 2048; g.lda = 2048; g.ldb = 2048; g.K = 2048;
    Sched S; S.nM = (l == DEPTH - 1) ? bg * 8 : bg * 9; S.nN = 4; S.nB = 1; S.nw = G; S.wi = c; S.mode = 0; S.aTile = 256L * 2048 * 2; S.bTile = 256L * 2048 * 2; S.aBatch = 0; S.bBatch = 0; S.segmap = 0;
    EpiOut E; E.xg = p.out + (size_t)grp * bg * 2048 * 1024; E.cg_ = (float*)(p.ws + p.oCtx) + (size_t)grp * bg * 256 * 1024; E.modl = (const float*)(p.ws + p.oMod) + (size_t)l * 17 * 3072; E.bg = bg; E.grp = grp;
    pg8::gemm_phase<EpiOut>(lds, g, S, E);
}

__device__ __forceinline__ void phase_final(const P& p) {
    const int tid = tidx(), lane = tid & 63, w = tid >> 6, c = blockIdx.x, G = gridDim.x;
    f32x4 fw[4], v[4], vn[4];
#pragma unroll
    for (int i = 0; i < 4; ++i) fw[i] = *(const f32x4*)(p.fnorm_w + i * 256 + lane * 4);
    int row = c * 8 + w;
    if (row < NB * SEQ) {
#pragma unroll
        for (int i = 0; i < 4; ++i) v[i] = __builtin_nontemporal_load((const f32x4*)(p.out + (size_t)row * 1024 + i * 256 + lane * 4)); }
    for (; row < NB * SEQ; row += G * 8) {
        float* src = p.out + (size_t)row * 1024; float ss = 0.f;
        const int nrow = row + G * 8;
        if (nrow < NB * SEQ) {
#pragma unroll
            for (int i = 0; i < 4; ++i) vn[i] = __builtin_nontemporal_load((const f32x4*)(p.out + (size_t)nrow * 1024 + i * 256 + lane * 4)); }
#pragma unroll
        for (int i = 0; i < 4; ++i) ss += v[i][0] * v[i][0] + v[i][1] * v[i][1] + v[i][2] * v[i][2] + v[i][3] * v[i][3];
#pragma unroll
        for (int o = 32; o >= 1; o >>= 1) ss += __shfl_xor(ss, o);
        const float rs = rsqrtf(ss * (1.f / 1024.f) + 1e-6f);
#pragma unroll
        for (int i = 0; i < 4; ++i) { const int col = i * 256 + lane * 4; f32x4 y = v[i] * rs * fw[i];
#ifdef SCRUB
            for (int e = 0; e < 4; ++e) if (!(fabsf(y[e]) < 1e30f)) y[e] = 30.f;
#endif
            __builtin_nontemporal_store(y, (f32x4*)(src + col)); }
#pragma unroll
        for (int i = 0; i < 4; ++i) v[i] = vn[i];
    }
}


#ifdef DBG
DI float wsum(float v) {
#pragma unroll
    for (int o = 32; o >= 1; o >>= 1) v += __shfl_xor(v, o);
    return v; }
DI float bfr(float v) { return bf2f(cvt_pk_bf16(v, 0.f) & 0xffffu); }
DI float dotHW(const u16* a, const u16* b, int n, int lane) { float s = 0.f; for (int k = lane; k < n; k += 64) s += bf2f(a[k]) * bf2f(b[k]); return wsum(s); }
__global__ void __launch_bounds__(NT) dbg_copy(P p) {
    const size_t gtid = (size_t)blockIdx.x * NT + threadIdx.x, gsz = (size_t)gridDim.x * NT; const size_t Mg = (size_t)p.bg * 2304;
    const u32x4* a = (const u32x4*)(p.ws + p.oZF); u32x4* da = (u32x4*)(p.ws + p.oDbg);
    for (size_t i = gtid; i < Mg * 1024 / 8; i += gsz) da[i] = a[i];
    const u32x4* b = (const u32x4*)(p.ws + p.oZB); u32x4* db = da + Mg * 1024 / 8;
    for (size_t i = gtid; i < Mg * 1024 / 8; i += gsz) db[i] = b[i];
    const u32x4* g = (const u32x4*)(p.ws + p.oG2); u32x4* dg = db + Mg * 1024 / 8;
    for (size_t i = gtid; i < Mg * 2048 / 8; i += gsz) dg[i] = g[i];
}
__global__ void __launch_bounds__(NT) dbg_check(P p) {
    __shared__ unsigned flsh[32];
    const int tid = threadIdx.x, lane = tid & 63, w = tid >> 6, bg = p.bg; const size_t Mg = (size_t)bg * 2304;
    unsigned* fl = flsh;
    if (tid < 32) fl[tid] = 0u;
    __syncthreads();
    const u16* H = (const u16*)(p.ws + p.oH); const u16* WinT = (const u16*)(p.ws + p.oWinT); const u16* V = (const u16*)(p.ws + p.oV); const u16* Q = (const u16*)(p.ws + p.oQ);
    const u16* ZFo = (const u16*)(p.ws + p.oZF); const u16* ZBo = (const u16*)(p.ws + p.oZB); const u16* G2 = (const u16*)(p.ws + p.oG2);
    const u16* dZF = (const u16*)(p.ws + p.oDbg); const u16* dZB = dZF + Mg * 1024; const u16* dG2 = dZB + Mg * 1024;
    const u16* WcsT = (const u16*)(p.ws + p.oWcsT); const u16* Wu = (const u16*)(p.ws + p.oWu); const u16* WpT = (const u16*)(p.ws + p.oWpT);
    const u16* Ttx = (const u16*)(p.ws + p.oTtx); const u16* Dx = (const u16*)(p.ws + p.oDx); const u16* WoutT = (const u16*)(p.ws + p.oWoutT);
    const float* mod = (const float*)(p.ws + p.oMod); const float* lbs = (const float*)(p.ws + p.oLbs);
#define CHKS(idx, fast, ref, tol, scl) do { const float f_ = (fast), r_ = (ref); if (lane == 0 && !(fabsf(f_ - r_) <= (tol) * (fabsf(r_) + (scl)))) atomicOr((unsigned*)&fl[idx], 1u); } while (0)
#define CHK(idx, fast, ref, tol) CHKS(idx, fast, ref, tol, 0.05f)
    for (int s = w; s < 16; s += 8) {
        const int si = s & 3, sj = s >> 2; const int row = si == 0 ? 0 : (si == 1 ? 4099 : (si == 2 ? bg * 2048 - 1 : bg * 2048 + 300)); const int col = sj == 0 ? 1 : (sj == 1 ? 130 : (sj == 2 ? 517 : 1023));
        { const int r = si == 3 ? 16 : si * 5, n = col * 3; float a = 0.f; for (int k = lane; k < 1024; k += 64) { const float cv = r < 16 ? p.c[r * 1024 + k] : p.c_ctx[k]; a += silu(cv) * p.w_ada[(size_t)k * 3072 + n]; }
          a = wsum(a) + p.b_ada[n]; CHK(1, mod[(size_t)r * 3072 + n], a, 1e-3f); }
        { const int n = col * 7, k = (row * 13) & 1023; CHK(2, bf2f(WinT[(size_t)n * 1024 + k]), bfr(p.w_in[(size_t)k * NIN + n]), 1e-6f); }
        { const float* src; int mr; if (row < bg * 2048) { src = p.x + (size_t)row * 1024; mr = row >> 11; } else { src = p.ctx + (size_t)(row - bg * 2048) * 1024; mr = 16; }
          float ss = 0.f, xv = 0.f; for (int k = lane; k < 1024; k += 64) { float v = src[k];
              if (row < bg * 2048) { const int t = row & 2047, i = k & 255; const float om = powf(10000.f, -(float)i / 256.f); const float pp = (float)(k < 512 ? (t >> 6) : (t & 63)); v += ((k >> 8) & 1) ? cosf(pp * om) : sinf(pp * om); }
              ss += v * v; if (k == col) xv = v; }
          ss = wsum(ss); xv = wsum(xv); const float y = xv * rsqrtf(ss / 1024.f + 1e-6f) * p.norm_w[col] * (1.f + mod[(size_t)mr * 3072 + 1024 + col]) + mod[(size_t)mr * 3072 + col];
          CHK(3, bf2f(H[(size_t)row * 1024 + col]), y, 1e-2f); }
        const u16* hrow = H + (size_t)row * 1024;
        { float d = dotHW(hrow, WinT + (size_t)col * 1024, 1024, lane); CHK(4, bf2f(V[(size_t)row * 1024 + col]), d, 1e-2f);
          d = dotHW(hrow, WinT + (size_t)(1024 + col) * 1024, 1024, lane); CHK(5, h2f(dZF[(size_t)row * 1024 + col]), d, 1e-2f);
          d = dotHW(hrow, WinT + (size_t)(2048 + col) * 1024, 1024, lane); CHK(5, h2f(dZB[(size_t)row * 1024 + col]), d, 1e-2f);
          d = dotHW(hrow, WinT + (size_t)(3072 + col) * 1024, 1024, lane); CHK(6, bf2f(Q[(size_t)row * 1024 + col]), silu(d), 1e-2f);
          d = dotHW(hrow, WinT + (size_t)(4096 + col) * 1024, 1024, lane); CHK(7, bf2f(dG2[(size_t)row * 2048 + col]), silu(d), 1e-2f);
          d = dotHW(hrow, WinT + (size_t)(6144 + col) * 1024, 1024, lane); CHK(7, bf2f(dG2[(size_t)row * 2048 + 1024 + col]), silu(d), 1e-2f); }
        const int g = si, n256 = col & 255, half = sj & 1, j = half * 256 + n256, cin = (row * 7 + 3) & 255;
        { float a = 0.f; for (int cp = lane; cp < 256; cp += 64) { const float th = (float)((cin * cp) & 255) / 128.f; a += (half ? sinpif(th) : cospif(th)) * p.w_four[((size_t)g * 256 + cp) * 256 + n256]; }
          a = wsum(a); CHK(8, bf2f(WcsT[((size_t)g * 512 + j) * 256 + cin]), a, 1e-2f); }
        { const int k = (row * 13) & 1023; const float d = dotHW(WcsT + ((size_t)g * 512 + j) * 256, Wu + (size_t)k * 1024 + g * 256, 256, lane); CHK(9, bf2f(WpT[((size_t)g * 512 + j) * 1024 + k]), d, 1e-2f); }
        if (row < bg * 2048) { const int bl = row >> 11, l = row & 2047; const float fast = bf2f(Ttx[(((size_t)(bl * 4 + g) * 256 + n256) * 2 + half) * 2048 + l]);
          const float d = dotHW(WpT + ((size_t)g * 512 + j) * 1024, hrow, 1024, lane); CHK(10, fast, d, 1e-2f);
          float a = 0.f; for (int ci = 0; ci < 256; ++ci) { const float u = dotHW(hrow, WinT + (size_t)(5120 + g * 256 + ci) * 1024, 1024, lane); float wc = 0.f;
              for (int cp = lane; cp < 256; cp += 64) { const float th = (float)((ci * cp) & 255) / 128.f; wc += (half ? sinpif(th) : cospif(th)) * p.w_four[((size_t)g * 256 + cp) * 256 + n256]; }
              a += u * wsum(wc); }
          CHKS(11, fast, a, 2e-2f, 10.f); }
        if (row < bg * 2048) { const int bl = row >> 11, lp = row & 2047; const u16* tt = Ttx + ((size_t)(bl * 4 + g) * 256 + n256) * 4096; const float sc = 1.f / sqrtf(2048.f * 256.f);
          const float gate = bf2f(dG2[(size_t)row * 2048 + 1024 + g * 256 + n256]), fast = bf2f(G2[(size_t)row * 2048 + 1024 + g * 256 + n256]), bb = p.b_four[g * 256 + n256];
          const float d = dotHW(Dx + (size_t)lp * 4096, tt, 4096, lane); CHK(14, fast, (d * sc + bb) * gate, 2e-2f);
          float a = 0.f; for (int l = lane; l < 2048; l += 64) { const float th = (float)((l * lp) & 2047) / 1024.f; a += cospif(th) * bf2f(tt[l]) - sinpif(th) * bf2f(tt[2048 + l]); }
          a = wsum(a); CHK(15, fast, (a * sc + bb) * gate, 2e-2f); }
        { const int hh = col >> 7; float ss = 0.f, ov = 0.f; for (int e = lane; e < 128; e += 64) { const float o = bf2f(ZFo[(size_t)row * 1024 + hh * 128 + e]) + bf2f(ZBo[(size_t)row * 1024 + hh * 128 + e]); ss += o * o; if (hh * 128 + e == col) ov = o; }
          ss = wsum(ss); ov = wsum(ov); const float y = ov * rsqrtf(ss / 128.f + 1e-6f) * p.hn_w[col] * bf2f(dG2[(size_t)row * 2048 + col]); CHK(16, bf2f(G2[(size_t)row * 2048 + col]), y, 2e-2f); }
        if (row < bg * 2048) { const float d = dotHW(G2 + (size_t)row * 2048, WoutT + (size_t)col * 2048, 2048, lane); const int t = row & 2047, i = col & 255; const float om = powf(10000.f, -(float)i / 256.f);
          const float pp = (float)(col < 512 ? (t >> 6) : (t & 63)); const float x0 = p.x[(size_t)row * 1024 + col] + (((col >> 8) & 1) ? cosf(pp * om) : sinf(pp * om));
          CHK(17, p.out[(size_t)row * 1024 + col], x0 + mod[(size_t)(row >> 11) * 3072 + 2048 + col] * d, 2e-2f); }
    }
    { const int dir = w & 1, sidx = w >> 1; const int bl = sidx & 1, hh = (sidx * 3 + 1) & 7, e = (sidx * 37 + 5) & 127; const int tgt = sidx < 2 ? 37 : (sidx == 2 ? 5 : -100);
      const u16* Zs = dir ? dZB : dZF; const u16* Oo = dir ? ZBo : ZFo; const float* lb = lbs + (dir * 4 + 0) * 1024 + hh * 128;
      float s0 = 0.f, s1 = 0.f, o = 0.f; const float l0 = 1.f - lb[lane], l1 = 1.f - lb[lane + 64]; int outrow = 0;
      for (int part = 0; part < 2; ++part) { const int Lp = part ? 2048 : 256, base = part ? bl * 2048 : bg * 2048 + bl * 256; int nsteps;
          if (part == 0) nsteps = tgt < 0 ? 101 : 256; else nsteps = tgt < 0 ? 0 : tgt + 1;
          for (int st = 0; st < nsteps; ++st) { const int row = base + (dir ? Lp - 1 - st : st); const size_t ro = (size_t)row * 1024 + hh * 128;
              const float z0 = h2f(Zs[ro + lane]), z1 = h2f(Zs[ro + lane + 64]); const float k0 = l0 / (1.f + expf(z0)), k1 = l1 / (1.f + expf(z1));
              const float f0 = fmaxf(1.f - k0, 1e-6f), f1 = fmaxf(1.f - k1, 1e-6f); const float v = bf2f(V[ro + e]);
              s0 = f0 * s0 + k0 * v; s1 = f1 * s1 + k1 * v; o = wsum(s0 * bf2f(Q[ro + lane]) + s1 * bf2f(Q[ro + lane + 64])); outrow = row; } }
      CHKS(12 + dir, bf2f(Oo[(size_t)outrow * 1024 + hh * 128 + e]), o, 2e-2f, 3.f); }
    __syncthreads();
    __shared__ unsigned cnt[4];
    if (tid < 4) cnt[tid] = 0u;
    __syncthreads();
    { unsigned c0 = 0, c1 = 0, c2 = 0;
      for (size_t i = tid; i < Mg * 1024; i += NT) { if (!(fabsf(bf2f(ZFo[i])) < 1e30f)) ++c0; if (!(fabsf(bf2f(ZBo[i])) < 1e30f)) ++c1; const size_t gi = (i >> 10) * 2048 + (i & 1023); if (!(fabsf(bf2f(G2[gi])) < 1e30f)) ++c2; }
      atomicAdd(&cnt[0], c0); atomicAdd(&cnt[1], c1); atomicAdd(&cnt[2], c2); }
    __syncthreads();
    int early = 0;
    for (int i = 1; i <= 13; ++i) if (fl[i]) early = 1;
    const int bitsA = early | ((cnt[0] | cnt[1]) ? 2 : 0) | (cnt[2] ? 4 : 0), bitsB = (fl[14] ? 1 : 0) | (fl[15] ? 2 : 0) | (fl[16] ? 4 : 0) | (fl[17] ? 8 : 0);
    const float val = 4.f * (float)bitsA;
    for (size_t i = tid; i < (size_t)NB * SEQ * DM; i += NT) p.out[i] = val;
    __syncthreads();
    if (tid == 0) p.out[0] = 100.f * (float)(1 + bitsB);
}
#endif


template <bool COOP>
__global__ void __launch_bounds__(NT, 2) fwd_kernel(P p0, int ph_lo, int ph_hi) {
    extern __shared__ __attribute__((aligned(16))) unsigned char shm[];
    LAS unsigned char* lds = (LAS unsigned char*)shm;
    const int nlp = DEPTH * p0.ng * 5, last = 2 + nlp;
    if (COOP) { if (threadIdx.x < 4) ((volatile LAS unsigned*)(lds + 131072))[threadIdx.x] = 0u;
        if (blockIdx.x == 0) { unsigned* bw = (unsigned*)(p0.ws + p0.oBar); for (int i = threadIdx.x; i < XCD_BAR_WORDS + 64 * 64; i += NT) __hip_atomic_store(bw + i, 0u, __ATOMIC_RELAXED, __HIP_MEMORY_SCOPE_AGENT); }
        __syncthreads(); }
    for (int ph = ph_lo; ph < ph_hi; ++ph) {
#ifdef SPIN_TYPE
        const int sty = ph == 0 ? 0 : (ph == 1 ? 1 : (ph == last ? 7 : 2 + (ph - 2) % 5));
        if (sty == SPIN_TYPE && __lane_id() == 0) ((volatile unsigned long long*)(p0.ws + p0.oModPart))[blockIdx.x * 8] = wall_clock64();
#endif
        P p = p0;
        { unsigned long long a = (unsigned long long)p.ws, b = (unsigned long long)p.out; asm volatile("" : "+s"(a), "+s"(b)); p.ws = (unsigned char*)a; p.out = (float*)b; }
#ifdef DBG
        if (ph == 0) phase_p0a(p, lds); else if (ph == 1) phase_p0b(p, lds); else if (ph == 2) phase_norm(p, 0, 0, blockIdx.x, gridDim.x); else if (ph == 3) phase_gemm_in(p, 0, lds);
        else if (ph == 5) phase_scan_f3(p, 0, 0, lds); else if (ph == 6) phase_combine(p, 0); else if (ph == 7) phase_gemm_out(p, 0, 0, lds);
        if (0) {}
#else
        if (ph == 0) { if (ONLY & 1) phase_p0a(p, lds); }
        else if (ph == 1) { if (ONLY & 2) phase_p0b(p, lds); }
        else if (ph == last) { if (ONLY & 4) phase_final(p); }
        else {
            const int k = ph - 2, lg = k / 5, sub = k % 5, l = lg / p.ng, grp = lg % p.ng;
            if (sub == 0) { if (lg > 0) continue; if (ONLY & 4) phase_norm(p, l, grp, blockIdx.x, gridDim.x); }
            else if (sub == 1) { if (ONLY & 8) phase_gemm_in(p, l, lds); }
            else if (sub == 2) { if (ONLY & 80) phase_scan_f3(p, l, grp, lds); }
            else if (sub == 3) { if (ONLY & 4) phase_combine(p, l); }
            else { if (ONLY & 32) phase_gemm_out(p, l, grp, lds); }
        }
#endif
        if (COOP) { if (ph + 1 < ph_hi) { if (ph == ph_lo) { cg::this_grid().sync(); xcd_barrier_post((unsigned*)(p0.ws + p0.oBar)); } else xcd_barrier((unsigned*)(p0.ws + p0.oBar), (volatile LAS unsigned*)(lds + 131072)); } }
#ifdef SPIN_TYPE
        if (sty == SPIN_TYPE) { const unsigned long long t0 = ((volatile unsigned long long*)(p0.ws + p0.oModPart))[blockIdx.x * 8]; const unsigned long long t1 = wall_clock64();
            while (wall_clock64() - t1 < t1 - t0) __builtin_amdgcn_s_sleep(8);
            cg::this_grid().sync(); }
#endif
    }
}

static size_t align_up(size_t v) { return (v + 4095) & ~(size_t)4095; }

extern "C" void kernel_launch(void* const* d_in, const int* in_sizes, int n_in, void* d_out, int out_size, void* d_ws, size_t ws_size, hipStream_t stream) {
    static int grid = 0;
    if (grid == 0) {
        int dev = 0, cus = 0;
        (void)hipGetDevice(&dev); (void)hipDeviceGetAttribute(&cus, hipDeviceAttributeMultiprocessorCount, dev);
        (void)hipFuncSetAttribute((const void*)fwd_kernel<true>, hipFuncAttributeMaxDynamicSharedMemorySize, LDS_BYTES);
        (void)hipFuncSetAttribute((const void*)fwd_kernel<false>, hipFuncAttributeMaxDynamicSharedMemorySize, LDS_BYTES);
        int per_cu = 0;
        (void)hipOccupancyMaxActiveBlocksPerMultiprocessor(&per_cu, (const void*)fwd_kernel<true>, NT, LDS_BYTES);
        if (per_cu < 1) per_cu = 1;
        grid = cus * 1;
        (void)hipGetLastError();
    }
    P p{};
    p.x = (const float*)d_in[0]; p.c = (const float*)d_in[1]; p.ctx = (const float*)d_in[2]; p.c_ctx = (const float*)d_in[3]; p.norm_w = (const float*)d_in[4];
    p.w_ada = (const float*)d_in[5]; p.b_ada = (const float*)d_in[6]; p.w_in = (const float*)d_in[7]; p.lower = (const float*)d_in[8]; p.hn_w = (const float*)d_in[9];
    p.w_four = (const float*)d_in[10]; p.b_four = (const float*)d_in[11]; p.w_out = (const float*)d_in[12]; p.fnorm_w = (const float*)d_in[13];
    p.out = (float*)d_out; p.ws = (unsigned char*)d_ws;
    auto layout = [&](int ng) -> size_t {
        const size_t bg = NB / ng, Mg = bg * 2304; size_t o = 0;
        p.ng = ng; p.bg = (int)bg;
        p.oWinT = o; o = align_up(o + (size_t)DEPTH * NIN * 1024 * 2);
        p.oWoutT = o; o = align_up(o + (size_t)DEPTH * 1024 * 2048 * 2);
        p.oWu = o; o = align_up(o + (size_t)DEPTH * 1024 * 1024 * 2);
        p.oWcsT = o; o = align_up(o + (size_t)16 * 512 * 256 * 2);
        p.oWpT = o; o = align_up(o + (size_t)DEPTH * 2048 * 1024 * 2);
        p.oDx = o; o = align_up(o + (size_t)2048 * 2048 * 2);
        p.oDc = o; o = align_up(o + (size_t)256 * 512 * 2);
        p.oPos = o; o = align_up(o + (size_t)2048 * 1024 * 4);
        p.oLbs = o; o = align_up(o + (size_t)2 * 4 * 1024 * 4);
        p.oModPart = o; o = align_up(o + (size_t)DEPTH * 8 * 17 * 3072 * 4);
        p.oMod = o; o = align_up(o + (size_t)DEPTH * 17 * 3072 * 4 + 64);
        p.oBar = o; o = align_up(o + (size_t)(XCD_BAR_WORDS + 64 * 64) * 4);
        p.oCtx = o; o = align_up(o + (size_t)NB * CTXL * DM * 4);
        p.oH = o; o = align_up(o + Mg * 1024 * 2);
        p.oV = o; o = align_up(o + Mg * 1024 * 2);
        p.oZF = o; o = align_up(o + Mg * 1024 * 2);
        p.oZB = o; o = align_up(o + Mg * 1024 * 2);
        p.oQ = o; o = align_up(o + Mg * 1024 * 2);
        p.oG2 = o; o = align_up(o + Mg * 2048 * 2);
        p.oTtx = o; o = align_up(o + bg * 4 * 256 * 2048 * 2);
        p.oH2 = o; o = align_up(o + Mg * 1024 * 2);
        p.oT1024 = o; o = align_up(o + bg * 1024 * 4);
        p.oTtc = o; o = align_up(o + bg * 4 * 256 * 512 * 2);
#ifdef DBG
        p.oDbg = o; o = align_up(o + Mg * 4096 * 2);
#endif
        return o;
    };
#ifdef DBG
    size_t need = layout(4);
#else
    size_t need = layout(2);
    if (need > ws_size) need = layout(4);
#endif
    if (need > ws_size) { fprintf(stderr, "kernel_launch: workspace too small (%zu < %zu)\n", ws_size, need); return; }
#ifdef DBG
    const int nph = 9;
#else
    const int nph = 2 + DEPTH * p.ng * 5 + 1;
#endif
#ifndef MULTI_LAUNCH
    int lo = 0, hi = nph;
    void* args[] = {&p, &lo, &hi};
    hipError_t e = hipLaunchCooperativeKernel((const void*)fwd_kernel<true>, dim3(grid), dim3(NT), args, LDS_BYTES, stream);
    if (e != hipSuccess) fprintf(stderr, "cooperative launch failed: %s (grid %d)\n", hipGetErrorString(e), grid);
#else
#ifdef DBG
    for (int ph = 0; ph < nph; ++ph) {
        if (ph == 4) hipLaunchKernelGGL(dbg_copy, dim3(grid), dim3(NT), 0, stream, p);
        else if (ph == 8) hipLaunchKernelGGL(dbg_check, dim3(1), dim3(NT), 0, stream, p);
        else hipLaunchKernelGGL(fwd_kernel<false>, dim3(grid), dim3(NT), LDS_BYTES, stream, p, ph, ph + 1);
    }
#else
    for (int ph = 0; ph < nph; ++ph) hipLaunchKernelGGL(fwd_kernel<false>, dim3(grid), dim3(NT), LDS_BYTES, stream, p, ph, ph + 1);
#endif
#endif
}
```

```cpp
#include <hip/hip_runtime.h>
#include <hip/hip_cooperative_groups.h>
#include <cstdio>
namespace cg = cooperative_groups;

#define LAS __attribute__((address_space(3)))
typedef unsigned short u16;
typedef short bf16x8 __attribute__((ext_vector_type(8)));
typedef float f32x4 __attribute__((ext_vector_type(4)));
typedef unsigned u32x4 __attribute__((ext_vector_type(4)));
typedef unsigned u32x2 __attribute__((ext_vector_type(2)));
#define DI __device__ __forceinline__

constexpr int DM = 1024, NB = 16, SEQ = 2048, DEPTH = 4, CTXL = 256, NIN = 7168;
constexpr int NT = 512;
constexpr int LDS_BYTES = 131072 + 16;
#ifndef ONLY
#define ONLY 255
#endif

struct P {
    const float *x, *c, *ctx, *c_ctx, *norm_w, *w_ada, *b_ada, *w_in, *lower, *hn_w, *w_four, *b_four, *w_out, *fnorm_w;
    float* out; unsigned char* ws;
    int ng, bg;
    size_t oWinT, oWoutT, oWu, oWcsT, oWpT, oDx, oDc, oPos, oLbs, oModPart, oMod, oCtx, oH, oV, oZF, oZB, oQ, oG2, oTtx, oTtc, oDbg, oBar, oH2, oT1024;
};

typedef __bf16 bf16v2 __attribute__((ext_vector_type(2)));
typedef float f32x2 __attribute__((ext_vector_type(2)));
DI unsigned cvt_pk_bf16(float lo, float hi) { const f32x2 v = {lo, hi}; const bf16v2 b = __builtin_convertvector(v, bf16v2); return __builtin_bit_cast(unsigned, b); }
DI float bf2f(unsigned h) { return __uint_as_float(h << 16); }
DI float bflo(unsigned w) { return __uint_as_float(w << 16); }
DI float bfhi(unsigned w) { return __uint_as_float(w & 0xffff0000u); }
DI unsigned pk_f16(float lo, float hi) { _Float16 a = (_Float16)lo, b = (_Float16)hi; return (unsigned)__builtin_bit_cast(unsigned short, a) | ((unsigned)__builtin_bit_cast(unsigned short, b) << 16); }
DI float h2f(unsigned h) { return (float)__builtin_bit_cast(_Float16, (unsigned short)h); }
DI int tidx() { int t = threadIdx.x; asm volatile("" : "+v"(t)); return t; }
DI float silu(float v) { return v * __builtin_amdgcn_rcpf(1.f + __expf(-v)); }

namespace pg8 {
constexpr int BM = 256, BK = 64, HALF = 128, HTB = HALF * BK * 2, STAGE_BYTES = 8 * HTB, NXCD = 8, WGM = 8;
DI int lds_byte(int r, int c) { const int st = (r >> 4) * 2 + (c >> 5), rr = r & 15, cc = c & 31, ob = rr * 64 + cc * 2; return st * 1024 + (ob ^ (((ob >> 9) & 1) << 5)); }
DI void stage_rc(int b, int& R, int& C) { const int st = b / 1024, sb = b % 1024, swz = sb ^ (((sb >> 9) & 1) << 5); R = (st >> 1) * 16 + swz / 64; C = (st & 1) * 32 + (swz % 64) / 2; }
DI int perm32(int rho) { const int n = rho >> 4, i = rho & 15; return 8 * (i >> 2) + 4 * n + (i & 3); }

struct Unit { int pm, pn, tag, pad; long aoff, boff; };
struct Gemm { const u16* A; const u16* Bt; int lda, ldb, K; };

struct Sched {
    int nM, nN, nB, nw, wi, mode;
    long aTile, bTile, aBatch, bBatch;
    int segmap;
    DI bool next(int i, Unit& u) const {
        const long L = (long)i * nw + wi;
        if (mode == 0) {
            const int nwg = nM * nN; if (L >= nwg) return false;
            int wgid = (int)L; { const int q = nwg / NXCD, r = nwg % NXCD, xcd = wgid % NXCD, off = wgid / NXCD; wgid = (xcd < r ? xcd * (q + 1) : r * (q + 1) + (xcd - r) * q) + off; }
            const int nig = WGM * nN, gid = wgid / nig, fm = gid * WGM, gsz = (nM - fm) < WGM ? (nM - fm) : WGM;
            u.pm = fm + ((wgid % nig) % gsz); u.pn = (wgid % nig) / gsz; u.tag = 0;
        } else if (mode == 4) {
            const long T = 256L * 1024 * 2; const int u1 = nM * 20, u2 = 40 * nB, u3 = 4 * nB;
            if (L >= u1 + u2 + u3) return false;
            u.pad = 0;
            if (L < u1) {
                int wgid = (int)L; { const int q = u1 / NXCD, r = u1 % NXCD, xcd = wgid % NXCD, off = wgid / NXCD; wgid = (xcd < r ? xcd * (q + 1) : r * (q + 1) + (xcd - r) * q) + off; }
                const int nig = WGM * 20, gid = wgid / nig, fm = gid * WGM, gsz = (nM - fm) < WGM ? (nM - fm) : WGM;
                u.pm = fm + ((wgid % nig) % gsz); u.pn = (wgid % nig) / gsz; u.tag = 0;
                const int s5 = u.pn >> 2, pnb = ((s5 < 4 ? s5 : 6) << 2) + (u.pn & 3);
                u.aoff = aBatch + (long)u.pm * T; u.boff = bBatch + (long)pnb * T;
            } else if (L < u1 + u2) {
                const int L2 = (int)L - u1, nx = 32 * nB;
                if (L2 < nx) { u.pm = L2 & 7; const int rest = L2 >> 3; u.pn = (rest >> 2) * 8 + (u.pm & 1) * 4 + (rest & 3); }
                else { const int L3 = L2 - nx; u.pm = L3 & 7; u.pn = nB * 8 + (L3 >> 3); }
                u.tag = 1; u.aoff = aTile + (long)u.pm * T; u.boff = bTile + (long)u.pn * T;
            } else {
                const int L3 = (int)L - u1 - u2; u.pm = L3 >> 2; u.pn = L3 & 3; u.tag = 2;
                u.aoff = aBatch + (long)(nB * 8 + u.pm) * T; u.boff = bBatch + (long)(16 + u.pn) * T;
            }
            return true;
        } else if (mode == 2) {
            const int nx = 32 * nB; if (L >= nx + 8 * nB) return false;
            if (L < nx) { u.pm = (int)(L & 7); const int rest = (int)(L >> 3); u.pn = (rest >> 2) * 8 + (u.pm & 1) * 4 + (rest & 3); }
            else { const int L2 = (int)L - nx; u.pm = L2 & 7; u.pn = nB * 8 + (L2 >> 3); }
            u.tag = 0;
        } else {
            const long tot = (long)nB * nM * nN; if (L >= tot) return false;
            const int per = nM * nN; u.tag = (int)(L / per); const int rem = (int)(L % per); u.pm = rem / nN; u.pn = rem % nN;
        }
        u.pad = 0;
        u.aoff = (long)u.tag * aBatch + (long)u.pm * aTile;
        int pnb = u.pn;
        if (segmap == 1) { const int s5 = pnb >> 2; pnb = ((s5 < 4 ? s5 : 6) << 2) + (pnb & 3); }
        else if (segmap == 2) pnb += 16;
        u.boff = (long)u.tag * bBatch + (long)pnb * bTile;
        return true;
    }
};

template <class Epi>
DI void gemm_phase(LAS unsigned char* lds, const Gemm g, const Sched& S, const Epi& E) {
    const int tid = tidx(), wid = __builtin_amdgcn_readfirstlane(tid >> 6), lane = tid & 63, wr = wid >> 2, wc = wid & 3, fr = lane & 15, fq = lane >> 4;
    const int K = g.K, nt = K / BK;
    unsigned voffA[2], voffB[2];
#pragma unroll
    for (int i = 0; i < 2; ++i) { int R, C; stage_rc(tid * 16 + i * 8192, R, C); const int Rb = Epi::PERM ? ((R & ~31) + perm32(R & 31)) : R;
        voffA[i] = (unsigned)(R * g.lda + C) * 2u; voffB[i] = (unsigned)(Rb * g.ldb + C) * 2u; }
    const size_t kstep = (size_t)(BK * 2);
    const size_t hstepA = (size_t)HALF * g.lda * 2, hstepB = (size_t)HALF * g.ldb * 2;
    const unsigned ldsw = (unsigned)wid * 1024u;
    const int aoff = lds_byte(wr * 64 + fr, fq * 8), boff = lds_byte(wc * 32 + fr, fq * 8);
#define PG8_SA(b, h) (((b) * 2 + (h)) * HTB)
#define PG8_SB(b, h) ((4 + (b) * 2 + (h)) * HTB)
#define PG8_STAGE(bufoff, gbase, voff) do { _Pragma("unroll") for (int _i = 0; _i < 2; ++_i) \
        __builtin_amdgcn_global_load_lds((const unsigned*)((const char*)(gbase) + (voff)[_i]), (LAS unsigned*)(lds + (bufoff) + ldsw + _i * 8192), 16, 0, 0); } while (0)
#define PG8_LDA(dst, b, h) do { _Pragma("unroll") for (int m = 0; m < 4; ++m) _Pragma("unroll") for (int k = 0; k < 2; ++k) dst[m][k] = *(const LAS bf16x8*)(lds + PG8_SA(b, h) + aoff + m * 2048 + k * 1024); } while (0)
#define PG8_LDB(dst, b, h) do { _Pragma("unroll") for (int n = 0; n < 2; ++n) _Pragma("unroll") for (int k = 0; k < 2; ++k) dst[n][k] = *(const LAS bf16x8*)(lds + PG8_SB(b, h) + boff + n * 2048 + k * 1024); } while (0)
#define PG8_MMA(ai, bj, At, Bt) do { __builtin_amdgcn_s_setprio(1); _Pragma("unroll") for (int m = 0; m < 4; ++m) _Pragma("unroll") for (int n = 0; n < 2; ++n) _Pragma("unroll") for (int k = 0; k < 2; ++k) \
        acc[ai][bj][m][n] = __builtin_amdgcn_mfma_f32_16x16x32_bf16(Bt[n][k], At[m][k], acc[ai][bj][m][n], 0, 0, 0); __builtin_amdgcn_s_setprio(0); } while (0)
#define PG8_WAIT_V(n) asm volatile("s_waitcnt vmcnt(" #n ")" ::: "memory")
#define PG8_WAIT_L(n) asm volatile("s_waitcnt lgkmcnt(" #n ")" ::: "memory")
#define PG8_BAR __builtin_amdgcn_s_barrier()
#define PG8_SCHED __builtin_amdgcn_sched_barrier(0)
    Unit cur, nxt; int ui = 0;
    if (!S.next(0, cur)) return;
    f32x4 acc[2][2][4][2];
#pragma unroll
    for (int a = 0; a < 2; ++a)
#pragma unroll
        for (int b = 0; b < 2; ++b)
#pragma unroll
            for (int m = 0; m < 4; ++m)
#pragma unroll
                for (int n = 0; n < 2; ++n) acc[a][b][m][n] = (f32x4){0.f, 0.f, 0.f, 0.f};
    bf16x8 At[4][2], B0[2][2], B1[2][2];
    const char* cA = (const char*)g.A + cur.aoff; const char* cB = (const char*)g.Bt + cur.boff;
    PG8_STAGE(PG8_SB(0, 0), cB, voffB); PG8_STAGE(PG8_SA(0, 0), cA, voffA); PG8_STAGE(PG8_SB(0, 1), cB + hstepB, voffB); PG8_STAGE(PG8_SA(0, 1), cA + hstepA, voffA);
    if (wr == 1) PG8_BAR;
    PG8_WAIT_V(4); PG8_BAR;
    PG8_STAGE(PG8_SB(1, 0), cB + kstep, voffB); PG8_STAGE(PG8_SA(1, 0), cA + kstep, voffA); PG8_STAGE(PG8_SB(1, 1), cB + hstepB + kstep, voffB);
    PG8_WAIT_V(6); PG8_BAR;
    for (;;) {
        const bool has_next = S.next(ui + 1, nxt);
        const char* nA = has_next ? (const char*)g.A + nxt.aoff : cA; const char* nB = has_next ? (const char*)g.Bt + nxt.boff : cB;
        for (int t = 0; t < nt; t += 2) {
            const bool last = (t == nt - 2);
            const char* a1 = cA + (size_t)(t + 1) * kstep;
            const char* a2 = last ? nA : cA + (size_t)(t + 2) * kstep; const char* b2 = last ? nB : cB + (size_t)(t + 2) * kstep;
            const char* a3 = a2 + kstep; const char* b3 = b2 + kstep;
            PG8_LDB(B0, 0, 0); PG8_SCHED; PG8_LDA(At, 0, 0); PG8_STAGE(PG8_SA(1, 1), a1 + hstepA, voffA);
            PG8_WAIT_L(8); PG8_BAR; PG8_WAIT_L(0); PG8_MMA(0, 0, At, B0); PG8_BAR; PG8_SCHED;
            PG8_LDB(B1, 0, 1); PG8_STAGE(PG8_SB(0, 0), b2, voffB);
            PG8_BAR; PG8_WAIT_L(0); PG8_MMA(0, 1, At, B1); PG8_BAR;
            PG8_LDA(At, 0, 1); PG8_STAGE(PG8_SA(0, 0), a2, voffA);
            PG8_BAR; PG8_WAIT_L(0); PG8_MMA(1, 0, At, B0); PG8_BAR; PG8_SCHED;
            PG8_STAGE(PG8_SB(0, 1), b2 + hstepB, voffB);
            PG8_WAIT_V(6); PG8_BAR; PG8_MMA(1, 1, At, B1); PG8_BAR;
            PG8_LDB(B0, 1, 0); PG8_SCHED; PG8_LDA(At, 1, 0); PG8_STAGE(PG8_SA(0, 1), a2 + hstepA, voffA);
            PG8_WAIT_L(8); PG8_BAR; PG8_WAIT_L(0); PG8_MMA(0, 0, At, B0); PG8_BAR; PG8_SCHED;
            PG8_LDB(B1, 1, 1); PG8_STAGE(PG8_SB(1, 0), b3, voffB);
            PG8_BAR; PG8_WAIT_L(0); PG8_MMA(0, 1, At, B1); PG8_BAR;
            PG8_LDA(At, 1, 1); PG8_STAGE(PG8_SA(1, 0), a3, voffA);
            PG8_BAR; PG8_WAIT_L(0); PG8_MMA(1, 0, At, B0); PG8_BAR; PG8_SCHED;
            PG8_STAGE(PG8_SB(1, 1), b3 + hstepB, voffB);
            PG8_WAIT_V(6); PG8_BAR; PG8_MMA(1, 1, At, B1); PG8_BAR;
        }
        E(acc, cur, wr, wc, fr, fq);
        if (!has_next) break;
#pragma unroll
        for (int a = 0; a < 2; ++a)
#pragma unroll
            for (int b = 0; b < 2; ++b)
#pragma unroll
                for (int m = 0; m < 4; ++m)
#pragma unroll
                    for (int n = 0; n < 2; ++n) acc[a][b][m][n] = (f32x4){0.f, 0.f, 0.f, 0.f};
        cur = nxt; cA = nA; cB = nB; ++ui;
    }
    PG8_WAIT_V(0);
    if (wr == 0) PG8_BAR;
    PG8_BAR;
#undef PG8_SA
#undef PG8_SB
#undef PG8_STAGE
#undef PG8_LDA
#undef PG8_LDB
#undef PG8_MMA
#undef PG8_WAIT_V
#undef PG8_WAIT_L
#undef PG8_BAR
#undef PG8_SCHED
}
}
using pg8::Unit; using pg8::Gemm; using pg8::Sched; using pg8::HALF;
typedef f32x4 Acc[2][2][4][2];

struct EpiIn {
    static constexpr bool PERM = true;
    u16 *V, *ZF, *ZB, *Q, *G2; int forced, rowbase;
    const float* lbl;
    DI void operator()(const Acc& acc, const Unit& u, int wr, int wc, int fr, int fq) const {
        const int s6 = forced >= 0 ? forced : ((u.pn >> 2) < 4 ? (u.pn >> 2) : 5), cw = (u.pn & 3) * 256;
        u16* base; int ld = 1024, mode = 0, cofs = cw;
        if (s6 == 0) base = V; else if (s6 == 1) { base = ZF; mode = 1; } else if (s6 == 2) { base = ZB; mode = 1; }
        else if (s6 == 3) { base = Q; mode = 2; } else if (s6 == 4) { base = G2; ld = 2048; mode = 2; } else { base = G2; ld = 2048; mode = 2; cofs = 1024 + cw; }
        const int row0 = rowbase + u.pm * 256 + wr * 64 + fr, col0 = cofs + wc * 32 + 8 * fq;
        f32x4 om[2][2];
        if (mode == 1) { const float* lp = lbl + (s6 - 1) * 4096 + col0;
#pragma unroll
            for (int bj = 0; bj < 2; ++bj) { om[bj][0] = 1.f - *(const f32x4*)(lp + bj * HALF); om[bj][1] = 1.f - *(const f32x4*)(lp + bj * HALF + 4); } }
#pragma unroll
        for (int ai = 0; ai < 2; ++ai)
#pragma unroll
            for (int m = 0; m < 4; ++m) { u16* rowp = base + (size_t)(row0 + ai * HALF + m * 16) * ld + col0;
#pragma unroll
                for (int bj = 0; bj < 2; ++bj) { f32x4 v0 = acc[ai][bj][m][0], v1 = acc[ai][bj][m][1]; u32x4 w;
                    if (mode == 1) {
#pragma unroll
                        for (int j = 0; j < 4; ++j) { v0[j] = om[bj][0][j] * __builtin_amdgcn_rcpf(1.f + __expf(v0[j])); v1[j] = om[bj][1][j] * __builtin_amdgcn_rcpf(1.f + __expf(v1[j])); }
                        w.x = pk_f16(v0[0], v0[1]); w.y = pk_f16(v0[2], v0[3]); w.z = pk_f16(v1[0], v1[1]); w.w = pk_f16(v1[2], v1[3]); }
                    else { if (mode == 2) {
#pragma unroll
                            for (int j = 0; j < 4; ++j) { v0[j] = silu(v0[j]); v1[j] = silu(v1[j]); } }
                        w.x = cvt_pk_bf16(v0[0], v0[1]); w.y = cvt_pk_bf16(v0[2], v0[3]); w.z = cvt_pk_bf16(v1[0], v1[1]); w.w = cvt_pk_bf16(v1[2], v1[3]); }
                    *(u32x4*)(rowp + bj * HALF) = w; } }
    }
};
struct EpiBf {
    static constexpr bool PERM = true;
    u16* O; int ld; long batchStride;
    DI void operator()(const Acc& acc, const Unit& u, int wr, int wc, int fr, int fq) const {
        u16* base = O + (size_t)u.tag * batchStride;
        const int row0 = u.pm * 256 + wr * 64 + fr, col0 = u.pn * 256 + wc * 32 + 8 * fq;
#pragma unroll
        for (int ai = 0; ai < 2; ++ai)
#pragma unroll
            for (int m = 0; m < 4; ++m) { u16* rowp = base + (size_t)(row0 + ai * HALF + m * 16) * ld + col0;
#pragma unroll
                for (int bj = 0; bj < 2; ++bj) { const f32x4 v0 = acc[ai][bj][m][0], v1 = acc[ai][bj][m][1]; u32x4 w;
                    w.x = cvt_pk_bf16(v0[0], v0[1]); w.y = cvt_pk_bf16(v0[2], v0[3]); w.z = cvt_pk_bf16(v1[0], v1[1]); w.w = cvt_pk_bf16(v1[2], v1[3]);
                    *(u32x4*)(rowp + bj * HALF) = w; } }
    }
};
struct EpiTt {
    static constexpr bool PERM = true;
    u16 *Ttx, *Ttc; int bg;
    DI void operator()(const Acc& acc, const Unit& u, int wr, int wc, int fr, int fq) const {
        const int g = u.pm >> 1, half = u.pm & 1;
        u16* base; int Lp, bl;
        if (u.pn < bg * 8) { bl = u.pn >> 3; Lp = 1024; base = Ttx + (size_t)(bl * 4 + g) * 256 * 2048 + (u.pn & 7) * 256; }
        else { bl = u.pn - bg * 8; Lp = 256; base = Ttc + (size_t)(bl * 4 + g) * 256 * 512 + half * 256; }
        const int n0 = wr * 64 + fr, col0 = wc * 32 + 8 * fq;
#pragma unroll
        for (int ai = 0; ai < 2; ++ai)
#pragma unroll
            for (int m = 0; m < 4; ++m) { u16* rowp = base + (size_t)(n0 + ai * HALF + m * 16) * (2 * Lp) + col0;
#pragma unroll
                for (int bj = 0; bj < 2; ++bj) { const f32x4 v0 = acc[ai][bj][m][0], v1 = acc[ai][bj][m][1]; u32x4 w;
                    w.x = cvt_pk_bf16(v0[0], v0[1]); w.y = cvt_pk_bf16(v0[2], v0[3]); w.z = cvt_pk_bf16(v1[0], v1[1]); w.w = cvt_pk_bf16(v1[2], v1[3]);
                    *(u32x4*)(rowp + bj * HALF) = w; } }
    }
};
struct EpiB {
    static constexpr bool PERM = true;
    EpiIn in; EpiTt tt; int bg;
    DI void operator()(const Acc& acc, const Unit& u, int wr, int wc, int fr, int fq) const {
        if (u.tag == 1) tt(acc, u, wr, wc, fr, fq);
        else { EpiIn e = in; e.forced = (u.tag == 2) ? 4 : -1; e.rowbase = (u.tag == 2) ? bg * 2048 : 0; e(acc, u, wr, wc, fr, fq); }
    }
};
struct EpiF3 {
    static constexpr bool PERM = true;
    u16* G2; const float* bias; const float* t1024; float scale; int rowbase, Lp;
    DI void operator()(const Acc& acc, const Unit& u, int wr, int wc, int fr, int fq) const {
        const int bl = u.tag >> 2, g = u.tag & 3;
        const int row0 = rowbase + bl * Lp + u.pm * 256 + wr * 64 + fr, col0 = wc * 32 + 8 * fq;
        const float* bp = bias + g * 256 + col0;
        f32x4 bv[2][2];
#pragma unroll
        for (int bj = 0; bj < 2; ++bj) { bv[bj][0] = *(const f32x4*)(bp + bj * HALF); bv[bj][1] = *(const f32x4*)(bp + bj * HALF + 4); }
        if (t1024) { const float* tp = t1024 + (size_t)bl * 1024 + g * 256 + col0; const float sg = (fr & 1) ? -scale : scale;
#pragma unroll
            for (int bj = 0; bj < 2; ++bj) { bv[bj][0] = bv[bj][0] + *(const f32x4*)(tp + bj * HALF) * sg; bv[bj][1] = bv[bj][1] + *(const f32x4*)(tp + bj * HALF + 4) * sg; } }
        u32x4 gc[2], gn[2];
        { const u16* rowp = G2 + (size_t)row0 * 2048 + 1024 + g * 256 + col0; gc[0] = *(const u32x4*)rowp; gc[1] = *(const u32x4*)(rowp + HALF); }
#pragma unroll
        for (int gi = 0; gi < 8; ++gi) { const int ai = gi >> 2, m = gi & 3;
            if (gi + 1 < 8) { const u16* rp2 = G2 + (size_t)(row0 + ((gi + 1) >> 2) * HALF + ((gi + 1) & 3) * 16) * 2048 + 1024 + g * 256 + col0; gn[0] = *(const u32x4*)rp2; gn[1] = *(const u32x4*)(rp2 + HALF); }
            u16* rowp = G2 + (size_t)(row0 + ai * HALF + m * 16) * 2048 + 1024 + g * 256 + col0;
#pragma unroll
            for (int bj = 0; bj < 2; ++bj) { const f32x4 v0 = acc[ai][bj][m][0] * scale + bv[bj][0], v1 = acc[ai][bj][m][1] * scale + bv[bj][1];
                const u32x4 gt = gc[bj]; u32x4 w;
                w.x = cvt_pk_bf16(v0[0] * bflo(gt.x), v0[1] * bfhi(gt.x)); w.y = cvt_pk_bf16(v0[2] * bflo(gt.y), v0[3] * bfhi(gt.y));
                w.z = cvt_pk_bf16(v1[0] * bflo(gt.z), v1[1] * bfhi(gt.z)); w.w = cvt_pk_bf16(v1[2] * bflo(gt.w), v1[3] * bfhi(gt.w));
                *(u32x4*)(rowp + bj * HALF) = w; }
            gc[0] = gn[0]; gc[1] = gn[1]; }
    }
};
struct EpiOut {
    static constexpr bool PERM = false;
    float *xg, *cg_; const float* modl; int bg, grp;
    DI void operator()(const Acc& acc, const Unit& u, int wr, int wc, int fr, int fq) const {
        const int r0 = u.pm * 256; float* dst; const float* gate;
        if (r0 < bg * 2048) { dst = xg + (size_t)r0 * 1024; gate = modl + (size_t)(grp * bg + (r0 >> 11)) * 3072 + 2048; }
        else { dst = cg_ + (size_t)(r0 - bg * 2048) * 1024; gate = modl + (size_t)16 * 3072 + 2048; }
        const int row0 = wr * 64 + fr, col0 = u.pn * 256 + wc * 32 + 4 * fq;
        f32x4 gv[2][2];
#pragma unroll
        for (int bj = 0; bj < 2; ++bj)
#pragma unroll
            for (int n = 0; n < 2; ++n) gv[bj][n] = *(const f32x4*)(gate + col0 + bj * HALF + n * 16);
        f32x4 cur[4], nxt[4];
        { const float* rowp = dst + (size_t)row0 * 1024 + col0;
#pragma unroll
          for (int t = 0; t < 4; ++t) cur[t] = __builtin_nontemporal_load((const f32x4*)(rowp + (t >> 1) * HALF + (t & 1) * 16)); }
#pragma unroll
        for (int gi = 0; gi < 8; ++gi) { const int ai = gi >> 2, m = gi & 3;
            if (gi + 1 < 8) { const int ai2 = (gi + 1) >> 2, m2 = (gi + 1) & 3; const float* rp2 = dst + (size_t)(row0 + ai2 * HALF + m2 * 16) * 1024 + col0;
#pragma unroll
                for (int t = 0; t < 4; ++t) nxt[t] = __builtin_nontemporal_load((const f32x4*)(rp2 + (t >> 1) * HALF + (t & 1) * 16)); }
            float* rowp = dst + (size_t)(row0 + ai * HALF + m * 16) * 1024 + col0;
#pragma unroll
            for (int t = 0; t < 4; ++t) __builtin_nontemporal_store(cur[t] + gv[t >> 1][t & 1] * acc[ai][t >> 1][m][t & 1], (f32x4*)(rowp + (t >> 1) * HALF + (t & 1) * 16));
#pragma unroll
            for (int t = 0; t < 4; ++t) cur[t] = nxt[t]; }
    }
};

DI void transpose_cvt(const float* src, u16* dst, int nl, int R, int C, LAS float* tile, int c, int G) {
    const int tid = tidx(), ntr = R / 64, ntc = C / 256, per = ntr * ntc;
    for (int t = c; t < nl * per; t += G) {
        const int l = t / per, rem = t % per, tr = rem / ntc, tc = rem % ntc;
        const float* s = src + ((size_t)l * R + tr * 64) * C + tc * 256;
        u16* d = dst + ((size_t)l * C + tc * 256) * R + tr * 64;
        __syncthreads();
        { const int c4 = (tid & 63) * 4, r0 = tid >> 6;
          f32x4 v[8];
#pragma unroll
          for (int i = 0; i < 8; ++i) v[i] = *(const f32x4*)(s + (size_t)(r0 + 8 * i) * C + c4);
#pragma unroll
          for (int i = 0; i < 8; ++i) { LAS float* tp = tile + (r0 + 8 * i) * 257 + c4; tp[0] = v[i][0]; tp[1] = v[i][1]; tp[2] = v[i][2]; tp[3] = v[i][3]; } }
        __syncthreads();
        { const int rg = (tid & 7) * 8, oc0 = tid >> 3;
#pragma unroll
          for (int i = 0; i < 4; ++i) { const int oc = oc0 + 64 * i; float v[8];
#pragma unroll
              for (int e = 0; e < 8; ++e) v[e] = tile[(rg + e) * 257 + oc];
              u32x4 w; w.x = cvt_pk_bf16(v[0], v[1]); w.y = cvt_pk_bf16(v[2], v[3]); w.z = cvt_pk_bf16(v[4], v[5]); w.w = cvt_pk_bf16(v[6], v[7]);
              *(u32x4*)(d + (size_t)oc * R + rg) = w; } }
    }
}

__device__ __forceinline__ void phase_p0a(const P& p, LAS unsigned char* lds) {
    const int tid = tidx(), c = blockIdx.x, G = gridDim.x;
    const size_t gtid = (size_t)c * NT + tid, gsz = (size_t)G * NT;
    for (int it = c; it < 192; it += G) {
        const int l = it / 48, kp = (it / 6) % 8, nc = it % 6;
        LAS float* sc = (LAS float*)lds;
        __syncthreads();
        for (int i = tid; i < 17 * 128; i += NT) { const int r = i >> 7, k = i & 127; const float v = r < 16 ? p.c[r * 1024 + kp * 128 + k] : p.c_ctx[kp * 128 + k]; sc[i] = silu(v); }
        __syncthreads();
        const int n = nc * 512 + tid;
        float acc[17];
#pragma unroll
        for (int r = 0; r < 17; ++r) acc[r] = 0.f;
        const float* w = p.w_ada + ((size_t)l * 1024 + kp * 128) * 3072 + n;
        for (int k = 0; k < 128; ++k) { const float wv = w[(size_t)k * 3072];
#pragma unroll
            for (int r = 0; r < 17; ++r) acc[r] += sc[r * 128 + k] * wv; }
        float* mp = (float*)(p.ws + p.oModPart) + (((size_t)l * 8 + kp) * 17) * 3072 + n;
#pragma unroll
        for (int r = 0; r < 17; ++r) mp[(size_t)r * 3072] = acc[r];
    }
    __syncthreads();
    transpose_cvt(p.w_in, (u16*)(p.ws + p.oWinT), DEPTH, 1024, NIN, (LAS float*)lds, c, G);
    transpose_cvt(p.w_out, (u16*)(p.ws + p.oWoutT), DEPTH, 2048, 1024, (LAS float*)lds, c, G);
    __syncthreads();
    { u16* Wu = (u16*)(p.ws + p.oWu);
      for (size_t i = gtid; i < (size_t)DEPTH * 1024 * 128; i += gsz) { const size_t lk = i >> 7; const int c8 = (int)(i & 127) * 8; const float* s = p.w_in + lk * NIN + 5120 + c8;
          const f32x4 a = *(const f32x4*)s, b = *(const f32x4*)(s + 4); u32x4 w; w.x = cvt_pk_bf16(a[0], a[1]); w.y = cvt_pk_bf16(a[2], a[3]); w.z = cvt_pk_bf16(b[0], b[1]); w.w = cvt_pk_bf16(b[2], b[3]);
          *(u32x4*)(Wu + lk * 1024 + c8) = w; } }
    { LAS float* ct = (LAS float*)lds; for (int i = tid; i < 256; i += NT) ct[i] = cospif((float)i / 128.f);
      __syncthreads();
      u16* Wc = (u16*)(p.ws + p.oWcsT);
      for (size_t o = gtid; o < (size_t)16 * 32 * 512; o += gsz) { const int j = (int)(o & 511), c8 = (int)((o >> 9) & 31) * 8, lg = (int)(o >> 14);
          const float* W = p.w_four + (size_t)lg * 65536 + (j & 255); const int ph = (j < 256) ? 0 : 192; float a[8];
#pragma unroll
          for (int e = 0; e < 8; ++e) a[e] = 0.f;
#pragma unroll 4
          for (int cp = 0; cp < 256; ++cp) { const float wv = W[(size_t)cp * 256];
#pragma unroll
              for (int e = 0; e < 8; ++e) a[e] += ct[((c8 + e) * cp + ph) & 255] * wv; }
          u32x4 w; w.x = cvt_pk_bf16(a[0], a[1]); w.y = cvt_pk_bf16(a[2], a[3]); w.z = cvt_pk_bf16(a[4], a[5]); w.w = cvt_pk_bf16(a[6], a[7]);
          *(u32x4*)(Wc + ((size_t)lg * 512 + j) * 256 + c8) = w; }
      __syncthreads(); }
    { u16* Dx = (u16*)(p.ws + p.oDx);
      for (size_t o = gtid; o < (size_t)2048 * 2048 / 8; o += gsz) { const int lp = (int)(o >> 8), k8 = (int)(o & 255) * 8; float v[8];
#pragma unroll
          for (int e = 0; e < 8; ++e) { const int kk = k8 + e; const int idx = (lp * (kk & 1023)) & 2047; const float a = (float)idx / 1024.f; v[e] = kk < 1024 ? cospif(a) : -sinpif(a); }
          u32x4 w; w.x = cvt_pk_bf16(v[0], v[1]); w.y = cvt_pk_bf16(v[2], v[3]); w.z = cvt_pk_bf16(v[4], v[5]); w.w = cvt_pk_bf16(v[6], v[7]);
          *(u32x4*)(Dx + o * 8) = w; }
      u16* Dc = (u16*)(p.ws + p.oDc);
      for (size_t o = gtid; o < (size_t)256 * 512 / 8; o += gsz) { const int lp = (int)(o >> 6), k8 = (int)(o & 63) * 8; float v[8];
#pragma unroll
          for (int e = 0; e < 8; ++e) { const int kk = k8 + e; const int idx = (lp * (kk & 255)) & 255; const float a = (float)idx / 128.f; v[e] = kk < 256 ? cospif(a) : -sinpif(a); }
          u32x4 w; w.x = cvt_pk_bf16(v[0], v[1]); w.y = cvt_pk_bf16(v[2], v[3]); w.z = cvt_pk_bf16(v[4], v[5]); w.w = cvt_pk_bf16(v[6], v[7]);
          *(u32x4*)(Dc + o * 8) = w; } }
    { float* pos = (float*)(p.ws + p.oPos);
      for (size_t o = gtid; o < (size_t)2048 * 1024; o += gsz) { const int t = (int)(o >> 10), d = (int)(o & 1023), i = d & 255;
          const float omega = exp2f(-(float)i * (13.287712379549449f / 256.f)); const float pp = (float)(d < 512 ? (t >> 6) : (t & 63)); const float ang = pp * omega;
          pos[o] = ((d >> 8) & 1) ? cosf(ang) : sinf(ang); } }
    { float* lbs = (float*)(p.ws + p.oLbs);
      for (size_t o = gtid; o < 2048; o += gsz) { const int dir = (int)(o >> 10), ch = (int)(o & 1023); float v[4], mx = -1e30f;
#pragma unroll
          for (int l = 0; l < 4; ++l) { v[l] = p.lower[(dir * 4 + l) * 1024 + ch]; mx = fmaxf(mx, v[l]); }
          float s = 0.f;
#pragma unroll
          for (int l = 0; l < 4; ++l) { v[l] = expf(v[l] - mx); s += v[l]; }
          float cum = 0.f; lbs[(dir * 4 + 0) * 1024 + ch] = 0.f;
#pragma unroll
          for (int l = 1; l < 4; ++l) { cum += v[l] / s; lbs[(dir * 4 + l) * 1024 + ch] = cum; } } }
}

__device__ __forceinline__ void phase_p0b(const P& p, LAS unsigned char* lds) {
    const int tid = tidx(), c = blockIdx.x, G = gridDim.x;
    const size_t gtid = (size_t)c * NT + tid, gsz = (size_t)G * NT;
    {
        for (int l = 0; l < DEPTH; ++l) {
            Gemm g; g.A = (const u16*)(p.ws + p.oWcsT) + (size_t)l * 4 * 512 * 256; g.Bt = (const u16*)(p.ws + p.oWu) + (size_t)l * 1024 * 1024; g.lda = 256; g.ldb = 1024; g.K = 256;
            Sched S; S.nM = 2; S.nN = 4; S.nB = 4; S.nw = G / 4; S.wi = ((c / (G / 4)) == l) ? (c % (G / 4)) : (1 << 20); S.mode = 1;     S.aTile = 256L * 256 * 2; S.bTile = 256L * 1024 * 2; S.aBatch = 512L * 256 * 2; S.bBatch = 256L * 2; S.segmap = 0;
            EpiBf E; E.O = (u16*)(p.ws + p.oWpT) + (size_t)l * 2048 * 1024; E.ld = 1024; E.batchStride = 512L * 1024;
            pg8::gemm_phase<EpiBf>(lds, g, S, E);
        }
    }
    { float* mod = (float*)(p.ws + p.oMod); const float* mp = (const float*)(p.ws + p.oModPart);
      for (size_t o = gtid; o < (size_t)DEPTH * 17 * 3072; o += gsz) { const int n = (int)(o % 3072), r = (int)(o / 3072) % 17, l = (int)(o / (3072 * 17)); float s = p.b_ada[l * 3072 + n];
#pragma unroll
          for (int kp = 0; kp < 8; ++kp) s += mp[(((size_t)l * 8 + kp) * 17 + r) * 3072 + n];
          mod[o] = s; } }
    { const float* pos = (const float*)(p.ws + p.oPos);
      const size_t nq = (size_t)NB * SEQ * DM / 4;
      size_t o = gtid;
      for (; o + 3 * gsz < nq; o += 4 * gsz) { f32x4 xv[4], pv[4];
#pragma unroll
          for (int u = 0; u < 4; ++u) { const size_t e = (o + u * gsz) * 4; xv[u] = *(const f32x4*)(p.x + e); pv[u] = *(const f32x4*)(pos + (e & ((size_t)SEQ * DM - 1))); }
#pragma unroll
          for (int u = 0; u < 4; ++u) *(f32x4*)(p.out + (o + u * gsz) * 4) = xv[u] + pv[u]; }
      for (; o < nq; o += gsz) { const size_t e = o * 4; *(f32x4*)(p.out + e) = *(const f32x4*)(p.x + e) + *(const f32x4*)(pos + (e & ((size_t)SEQ * DM - 1))); }
      float* cc = (float*)(p.ws + p.oCtx);
      for (size_t o = gtid; o < (size_t)NB * CTXL * DM / 4; o += gsz) *(f32x4*)(cc + o * 4) = *(const f32x4*)(p.ctx + o * 4); }
}

#define XB_TMO      128
#define XB_XCNT(j)  (256  + 64 * (j))
#define XB_XSUB(j)  (1280 + 64 * (j))
#define XB_XGEN(j)  (2304 + 64 * (j))
#define XB_TOP      3328
#define XB_TOPGEN   3392
#define XCD_BAR_WORDS 3456
#define XB_SPIN_CAP (1u << 18)
DI unsigned xb_ld(unsigned* p)              { return __hip_atomic_load(p, __ATOMIC_RELAXED, __HIP_MEMORY_SCOPE_AGENT); }
DI unsigned xb_add(unsigned* p, unsigned v) { return __hip_atomic_fetch_add(p, v, __ATOMIC_RELAXED, __HIP_MEMORY_SCOPE_AGENT); }
DI unsigned xb_xcc_id() { return (unsigned)__builtin_amdgcn_s_getreg((3 << 11) | 20) & 0xFu; }
#define XB_SPIN(cond, bar) do { unsigned _sp = 0; while (cond) { __builtin_amdgcn_s_sleep(1); \
    if ((++_sp & 255u) == 0u) { if (xb_ld(&(bar)[XB_TMO])) break; if (_sp > XB_SPIN_CAP) { atomicAdd(&(bar)[XB_TMO], 1u); break; } } } } while (0)
DI void xcd_barrier_post(unsigned* bar) { if (threadIdx.x == 0) (void)xb_add(&bar[XB_XCNT(xb_xcc_id())], 1u); }
DI void xcd_barrier_complete(unsigned* bar, unsigned x, unsigned& nloc, unsigned& nx) {
    const unsigned G = gridDim.x;
    unsigned sum, cnt, mine, sp = 0u;
    for (;;) {
        sum = 0u; cnt = 0u; mine = 0u;
#pragma unroll
        for (unsigned j = 0; j < 16; ++j) { const unsigned c = xb_ld(&bar[XB_XCNT(j)]); sum += c; cnt += (c > 0u) ? 1u : 0u; mine = (j == x) ? c : mine; }
        if (sum == G) break;
        __builtin_amdgcn_s_sleep(1);
        if ((++sp & 255u) == 0u) { if (xb_ld(&bar[XB_TMO])) break; if (sp > XB_SPIN_CAP) { atomicAdd(&bar[XB_TMO], 1u); break; } }
    }
    nloc = mine > 0u ? mine : 1u; nx = cnt > 0u ? cnt : 1u;
}
DI void xcd_barrier(unsigned* bar, volatile LAS unsigned* st) {
    asm volatile("s_waitcnt vmcnt(0)" ::: "memory");
    __syncthreads();
    if (threadIdx.x == 0) {
        const unsigned x = xb_xcc_id();
        __builtin_amdgcn_s_waitcnt(0);
        unsigned nloc = st[0], nx = st[1];
        if (nloc == 0u) { xcd_barrier_complete(bar, x, nloc, nx); st[0] = nloc; st[1] = nx; }
        const unsigned old = xb_add(&bar[XB_XSUB(x)], 1u);
        const unsigned gen = old / nloc;
        if (old + 1u == (gen + 1u) * nloc) {
            __builtin_amdgcn_fence(__ATOMIC_RELEASE, "agent");
            asm volatile("s_waitcnt vmcnt(0)" ::: "memory");
            const unsigned og = xb_add(&bar[XB_TOP], 1u);
            const unsigned tg = og / nx;
            if (og + 1u == (tg + 1u) * nx) xb_add(&bar[XB_TOPGEN], 1u);
            else XB_SPIN(xb_ld(&bar[XB_TOPGEN]) == tg, bar);
            __builtin_amdgcn_fence(__ATOMIC_ACQUIRE, "agent");
            xb_add(&bar[XB_XGEN(x)], 1u);
            asm volatile("s_waitcnt vmcnt(0)" ::: "memory");
        } else {
            XB_SPIN(xb_ld(&bar[XB_XGEN(x)]) == gen, bar);
            __builtin_amdgcn_fence(__ATOMIC_ACQUIRE, "agent");
            asm volatile("s_waitcnt vmcnt(0)" ::: "memory");
        }
    }
    __syncthreads();
}


DI void store_row(u16* dst, int lane, const f32x4 (&y)[4]) {
#pragma unroll
    for (int i = 0; i < 4; ++i) { u32x2 o; o.x = cvt_pk_bf16(y[i][0], y[i][1]); o.y = cvt_pk_bf16(y[i][2], y[i][3]); __builtin_nontemporal_store(o, (u32x2*)(dst + i * 256 + lane * 4)); }
}
__device__ __forceinline__ void phase_norm(const P& p, int l, int grp, int c, int G) {
    const int tid = tidx(), lane = tid & 63, w = tid >> 6, bg = p.bg;
    const float* modl = (const float*)(p.ws + p.oMod) + (size_t)l * 17 * 3072;
    const float* nw = p.norm_w + l * 1024;
    u16* H = (u16*)(p.ws + p.oH); u16* H2 = (u16*)(p.ws + p.oH2);
    const int nitems = bg * (1025 + 256);
    auto rows_of = [&](int it, const float*& pa, const float*& pb) {
        if (it < bg * 1025) { const int bl = it / 1025, li = it % 1025; const float* xb = p.out + ((size_t)(grp * bg + bl) * 2048) * 1024;
            pa = xb + (size_t)li * 1024; pb = (li > 0 && li < 1024) ? xb + (size_t)(2048 - li) * 1024 : pa; }
        else { pa = (const float*)(p.ws + p.oCtx) + ((size_t)grp * bg * 256 + (it - bg * 1025)) * 1024; pb = pa; } };
    f32x4 wv[4];
#pragma unroll
    for (int i = 0; i < 4; ++i) wv[i] = *(const f32x4*)(nw + i * 256 + lane * 4);
    f32x4 va[4], vb[4], na[4], nb[4];
    int it = c * 8 + w;
    if (it < nitems) { const float *pa, *pb; rows_of(it, pa, pb);
#pragma unroll
        for (int i = 0; i < 4; ++i) { va[i] = __builtin_nontemporal_load((const f32x4*)(pa + i * 256 + lane * 4)); vb[i] = __builtin_nontemporal_load((const f32x4*)(pb + i * 256 + lane * 4)); } }
    for (; it < nitems; it += G * 8) {
        const int nit = it + G * 8;
        if (nit < nitems) { const float *pa, *pb; rows_of(nit, pa, pb);
#pragma unroll
            for (int i = 0; i < 4; ++i) { na[i] = __builtin_nontemporal_load((const f32x4*)(pa + i * 256 + lane * 4)); nb[i] = __builtin_nontemporal_load((const f32x4*)(pb + i * 256 + lane * 4)); } }
        const bool isx = it < bg * 1025; const int bl = isx ? it / 1025 : 0, li = isx ? it % 1025 : 0;
        const float* md = modl + (size_t)(isx ? grp * bg + bl : 16) * 3072;
        float sa = 0.f, sb = 0.f;
#pragma unroll
        for (int i = 0; i < 4; ++i) { sa += va[i][0] * va[i][0] + va[i][1] * va[i][1] + va[i][2] * va[i][2] + va[i][3] * va[i][3]; sb += vb[i][0] * vb[i][0] + vb[i][1] * vb[i][1] + vb[i][2] * vb[i][2] + vb[i][3] * vb[i][3]; }
#pragma unroll
        for (int o = 32; o >= 1; o >>= 1) { sa += __shfl_xor(sa, o); sb += __shfl_xor(sb, o); }
        const float ra = rsqrtf(sa * (1.f / 1024.f) + 1e-6f), rb = rsqrtf(sb * (1.f / 1024.f) + 1e-6f);
        f32x4 y1[4], y2[4];
#pragma unroll
        for (int i = 0; i < 4; ++i) { const int col = i * 256 + lane * 4; const f32x4 sh = *(const f32x4*)(md + col), scl = *(const f32x4*)(md + 1024 + col) + 1.f;
            y1[i] = va[i] * ra * wv[i] * scl + sh; y2[i] = vb[i] * rb * wv[i] * scl + sh; }
        if (isx) {
            u16* Hb = H + (size_t)bl * 2048 * 1024; u16* H2b = H2 + (size_t)bl * 2048 * 1024;
            store_row(Hb + (size_t)li * 1024, lane, y1);
            if (li == 0) { store_row(H2b, lane, y1);
#pragma unroll
                for (int i = 0; i < 4; ++i) y2[i] = (f32x4){0.f, 0.f, 0.f, 0.f};
                store_row(H2b + (size_t)1024 * 1024, lane, y2); }
            else if (li < 1024) { store_row(Hb + (size_t)(2048 - li) * 1024, lane, y2);
                f32x4 e[4], o[4];
#pragma unroll
                for (int i = 0; i < 4; ++i) { e[i] = y1[i] + y2[i]; o[i] = y1[i] - y2[i]; }
                store_row(H2b + (size_t)li * 1024, lane, e); store_row(H2b + (size_t)(1024 + li) * 1024, lane, o); }
        } else {
            const int r = it - bg * 1025;
            store_row(H + ((size_t)bg * 2048 + r) * 1024, lane, y1); store_row(H2 + ((size_t)bg * 2048 + r) * 1024, lane, y1);
        }
#pragma unroll
        for (int i = 0; i < 4; ++i) { va[i] = na[i]; vb[i] = nb[i]; }
    }
}

__device__ __forceinline__ void phase_gemm_in(const P& p, int l, LAS unsigned char* lds) {
    const int c = blockIdx.x, G = gridDim.x, bg = p.bg; const int nMt = bg * 9;
    { const int tid = tidx(), lane = tid & 63, w = tid >> 6; const u16* Wp = (const u16*)(p.ws + p.oWpT) + (size_t)l * 2048 * 1024; const u16* H = (const u16*)(p.ws + p.oH); float* T = (float*)(p.ws + p.oT1024);
      for (int o0 = c * 8 + w; o0 < bg * 1024; o0 += 4 * G * 8) { u32x4 av[4][2], bv[4][2];
#pragma unroll
          for (int u = 0; u < 4; ++u) { const int o = o0 + u * G * 8; const int oo = o < bg * 1024 ? o : o0; const int bl = oo >> 10, j = oo & 1023, g = j >> 8, n = j & 255;
              const u16* a = Wp + (size_t)(g * 512 + n) * 1024 + lane * 16; const u16* b = H + ((size_t)bl * 2048 + 1024) * 1024 + lane * 16;
              av[u][0] = *(const u32x4*)a; av[u][1] = *(const u32x4*)(a + 8); bv[u][0] = *(const u32x4*)b; bv[u][1] = *(const u32x4*)(b + 8); }
          float sacc[4];
#pragma unroll
          for (int u = 0; u < 4; ++u) { sacc[u] = 0.f;
#pragma unroll
              for (int hh = 0; hh < 2; ++hh)
#pragma unroll
                  for (int e = 0; e < 4; ++e) sacc[u] += bflo(av[u][hh][e]) * bflo(bv[u][hh][e]) + bfhi(av[u][hh][e]) * bfhi(bv[u][hh][e]); }
#pragma unroll
          for (int m = 32; m >= 1; m >>= 1) {
#pragma unroll
              for (int u = 0; u < 4; ++u) sacc[u] += __shfl_xor(sacc[u], m); }
#pragma unroll
          for (int u = 0; u < 4; ++u) { const int o = o0 + u * G * 8; if (lane == 0 && o < bg * 1024) T[o] = sacc[u]; } } }
    { Gemm g; g.A = (const u16*)p.ws; g.Bt = (const u16*)p.ws; g.lda = 1024; g.ldb = 1024; g.K = 1024;
      Sched S; S.nM = nMt; S.nN = 20; S.nB = bg; S.nw = G; S.wi = c; S.mode = 4; S.segmap = 0;
      S.aBatch = (long)p.oH; S.bBatch = (long)(p.oWinT + (size_t)l * NIN * 1024 * 2); S.aTile = (long)(p.oWpT + (size_t)l * 2048 * 1024 * 2); S.bTile = (long)p.oH2;
      EpiB E; E.bg = bg;
      E.in.V = (u16*)(p.ws + p.oV); E.in.ZF = (u16*)(p.ws + p.oZF); E.in.ZB = (u16*)(p.ws + p.oZB); E.in.Q = (u16*)(p.ws + p.oQ); E.in.G2 = (u16*)(p.ws + p.oG2); E.in.forced = -1; E.in.rowbase = 0; E.in.lbl = (const float*)(p.ws + p.oLbs) + l * 1024;
      E.tt.Ttx = (u16*)(p.ws + p.oTtx); E.tt.Ttc = (u16*)(p.ws + p.oTtc); E.tt.bg = bg;
      pg8::gemm_phase<EpiB>(lds, g, S, E); }
}

__device__ __forceinline__ void scan_chain(const P& p, int l, int ci, LAS unsigned char* lds) {
    const int tid = tidx(), lane = tid & 63, w = __builtin_amdgcn_readfirstlane(tid >> 6), r = lane & 15, q = lane >> 4;
    const int bg = p.bg;
    const int bl = ci >> 4, dir = (ci >> 3) & 1, h = ci & 7;
    const u16* Vg = (const u16*)(p.ws + p.oV) + h * 128;
    const u16* Qg = (const u16*)(p.ws + p.oQ) + h * 128;
    u16* Zg = (u16*)(p.ws + (dir ? p.oZB : p.oZF)) + h * 128;
    constexpr int PB = 45568;
    const bool prepw = w >= 4; const int pw = w & 3, tg = q;
    const int dchA = 16 * pw + r, dchB = 64 + dchA;
    const int swA = (dchA * 2) ^ (tg << 5), swB = (dchB * 2) ^ (tg << 5);
    const float* lbp = (const float*)(p.ws + p.oLbs) + (dir * 4 + l) * 1024 + h * 128;
    const float omlA = 1.f - lbp[dchA], omlB = 1.f - lbp[dchB];
    const int pt = pw * 64 + lane, tokv = pt >> 4, cg8 = (pt & 15) * 8;
    f32x4 S0[8], S1[8];
#pragma unroll
    for (int i = 0; i < 8; ++i) { S0[i] = (f32x4){0.f, 0.f, 0.f, 0.f}; S1[i] = S0[i]; }
    auto rowof = [&](int cc, int t) -> int { const int part = cc >= 8, cidx = part ? cc - 8 : cc, pos = cidx * 32 + t, Lp = part ? 2048 : 256, base = part ? bl * 2048 : bg * 2048 + bl * 256;
        return base + (dir ? Lp - 1 - pos : pos); };
    u16 zcA[8], qcA[8], zcB[8], qcB[8], znA[8], qnA[8], znB[8], qnB[8]; u32x4 vc0, vc1, vn0, vn1;
#define SC_BAR() asm volatile("s_waitcnt lgkmcnt(0)\n\ts_barrier" ::: "memory")
    const long rstr = dir ? -1024 : 1024;
#define SC_LOAD(cc, ZA_, QA_, ZB_, QB_, V0_, V1_) do { const size_t ro = (size_t)rowof(cc, 8 * tg) * 1024; const u16* zp_ = Zg + ro; const u16* qp_ = Qg + ro; \
        _Pragma("unroll") for (int i = 0; i < 8; ++i) { ZA_[i] = zp_[i * rstr + dchA]; QA_[i] = qp_[i * rstr + dchA]; ZB_[i] = zp_[i * rstr + dchB]; QB_[i] = qp_[i * rstr + dchB]; } \
        const u16* vp_ = Vg + (size_t)rowof(cc, tokv) * 1024 + cg8; V0_ = *(const u32x4*)vp_; V1_ = *(const u32x4*)(vp_ + 16 * rstr); } while (0)
#define SC_PREP1(B_, Z_, Q_, dch, swc, oml) do { LAS float* E_ = (LAS float*)(B_ + 36352); float pr[8], k8[8]; \
        _Pragma("unroll") for (int i = 0; i < 8; ++i) { const float k = h2f(Z_[i]); k8[i] = k; pr[i] = fmaxf(1.f - k, 1e-6f); } \
        _Pragma("unroll") for (int i = 1; i < 8; ++i) pr[i] *= pr[i - 1]; \
        const float t0 = __shfl(pr[7], r), t1 = __shfl(pr[7], 16 + r), t2 = __shfl(pr[7], 32 + r), t3 = __shfl(pr[7], 48 + r); \
        const float er = fmaxf(t0 * t1, 1e-32f), eer = t2 * t3; \
          \
        const float sc = tg == 0 ? __builtin_amdgcn_rcpf(er) : (tg == 1 ? __builtin_amdgcn_rcpf(fmaxf(t1, 1e-32f)) : (tg == 2 ? 1.f : t2)); \
        if (tg == 3) E_[dch] = er * eer; \
        const float sc2 = tg == 0 ? 1.f : (tg == 1 ? t0 : (tg == 2 ? er : er * t2)); \
        unsigned kt[4]; \
        _Pragma("unroll") for (int i = 0; i < 8; i += 2) { const float r0 = fminf(fmaxf(sc * pr[i], 1e-32f), 1e32f), r1 = fminf(fmaxf(sc * pr[i + 1], 1e-32f), 1e32f); \
            const float qf0 = bf2f(Q_[i]), qf1 = bf2f(Q_[i + 1]); \
            const unsigned qq = cvt_pk_bf16(qf0 * r0, qf1 * r1); \
            const unsigned qh = cvt_pk_bf16(qf0 * (sc2 * pr[i]), qf1 * (sc2 * pr[i + 1])); \
            *(LAS u16*)(B_ + 36864 + (8 * tg + i) * 272 + swc) = (u16)(qh & 0xffffu); *(LAS u16*)(B_ + 36864 + (8 * tg + i + 1) * 272 + swc) = (u16)(qh >> 16); \
            *(LAS u16*)(B_ + (8 * tg + i) * 272 + swc) = (u16)(qq & 0xffffu); *(LAS u16*)(B_ + (8 * tg + i + 1) * 272 + swc) = (u16)(qq >> 16); \
            const unsigned kk = cvt_pk_bf16(k8[i] * __builtin_amdgcn_rcpf(r0), k8[i + 1] * __builtin_amdgcn_rcpf(r1)); \
            *(LAS u16*)(B_ + 8704 + (8 * tg + i) * 272 + swc) = (u16)(kk & 0xffffu); *(LAS u16*)(B_ + 8704 + (8 * tg + i + 1) * 272 + swc) = (u16)(kk >> 16); \
            kt[i >> 1] = cvt_pk_bf16(k8[i] * __builtin_amdgcn_rcpf(r0) * eer, k8[i + 1] * __builtin_amdgcn_rcpf(r1) * eer); } \
        *(LAS u32x4*)(B_ + 17408 + dch * 80 + tg * 16) = (u32x4){kt[0], kt[1], kt[2], kt[3]}; } while (0)
#define SC_PREP(par_, ZA_, QA_, ZB_, QB_, V0_, V1_) do { LAS unsigned char* Bp_ = lds + (par_) * PB; \
        SC_PREP1(Bp_, ZA_, QA_, dchA, swA, omlA); SC_PREP1(Bp_, ZB_, QB_, dchB, swB, omlB); \
        *(LAS u32x4*)(Bp_ + 27648 + tokv * 272 + cg8 * 2) = V0_; *(LAS u32x4*)(Bp_ + 27648 + (16 + tokv) * 272 + cg8 * 2) = V1_; } while (0)
    auto mfma_stage = [&](const int cc, const int par) {
        const LAS unsigned char* Qp = lds + par * PB; const LAS unsigned char* Kn = Qp + 8704; const LAS unsigned char* Kt = Qp + 17408; const LAS unsigned char* Vp = Qp + 27648;
        const LAS float* Eend = (const LAS float*)(Qp + 36352); const LAS unsigned char* Qh = Qp + 36864;
        const int sx0 = (r >> 3) << 5, sx1 = (2 + (r >> 3)) << 5;
        const int dv0 = 32 * pw + r, dv1 = dv0 + 16;
        f32x4 P00 = {0.f, 0.f, 0.f, 0.f}, P01 = P00, P11 = P00;
#pragma unroll
        for (int ks = 0; ks < 4; ++ks) {
            const int c0 = (ks * 64 + q * 16) ^ sx0, c1 = (ks * 64 + q * 16) ^ sx1;
            const bf16x8 a0 = *(const LAS bf16x8*)(Kn + r * 272 + c0), a1 = *(const LAS bf16x8*)(Kn + (16 + r) * 272 + c1);
            const bf16x8 b0 = *(const LAS bf16x8*)(Qp + r * 272 + c0), b1 = *(const LAS bf16x8*)(Qp + (16 + r) * 272 + c1);
            P00 = __builtin_amdgcn_mfma_f32_16x16x32_bf16(a0, b0, P00, 0, 0, 0);
            P01 = __builtin_amdgcn_mfma_f32_16x16x32_bf16(a0, b1, P01, 0, 0, 0);
            P11 = __builtin_amdgcn_mfma_f32_16x16x32_bf16(a1, b1, P11, 0, 0, 0); }
#pragma unroll
        for (int j = 0; j < 4; ++j) { if (4 * q + j > r) { P00[j] = 0.f; P11[j] = 0.f; } }
        u32x4 bp0, bp1;
        bp0.x = cvt_pk_bf16(P00[0], P00[1]); bp0.y = cvt_pk_bf16(P00[2], P00[3]); bp0.z = 0u; bp0.w = 0u;
        bp1.x = cvt_pk_bf16(P01[0], P01[1]); bp1.y = cvt_pk_bf16(P01[2], P01[3]); bp1.z = cvt_pk_bf16(P11[0], P11[1]); bp1.w = cvt_pk_bf16(P11[2], P11[3]);
        f32x4 O00 = {0.f, 0.f, 0.f, 0.f}, O01 = O00, O10 = O00, O11 = O00;
#pragma unroll
        for (int ks = 0; ks < 4; ++ks) {
            u32x4 a, a2;
            a.x = cvt_pk_bf16(S0[2 * ks][0], S0[2 * ks][1]); a.y = cvt_pk_bf16(S0[2 * ks][2], S0[2 * ks][3]); a.z = cvt_pk_bf16(S0[2 * ks + 1][0], S0[2 * ks + 1][1]); a.w = cvt_pk_bf16(S0[2 * ks + 1][2], S0[2 * ks + 1][3]);
            a2.x = cvt_pk_bf16(S1[2 * ks][0], S1[2 * ks][1]); a2.y = cvt_pk_bf16(S1[2 * ks][2], S1[2 * ks][3]); a2.z = cvt_pk_bf16(S1[2 * ks + 1][0], S1[2 * ks + 1][1]); a2.w = cvt_pk_bf16(S1[2 * ks + 1][2], S1[2 * ks + 1][3]);
            const u32x2 l0 = *(const LAS u32x2*)(Qh + r * 272 + (((32 * ks + 4 * q) * 2) ^ sx0)), h0 = *(const LAS u32x2*)(Qh + r * 272 + (((32 * ks + 16 + 4 * q) * 2) ^ sx0));
            const u32x2 l1 = *(const LAS u32x2*)(Qh + (16 + r) * 272 + (((32 * ks + 4 * q) * 2) ^ sx1)), h1 = *(const LAS u32x2*)(Qh + (16 + r) * 272 + (((32 * ks + 16 + 4 * q) * 2) ^ sx1));
            const u32x4 b0 = {l0.x, l0.y, h0.x, h0.y}, b1 = {l1.x, l1.y, h1.x, h1.y};
            O00 = __builtin_amdgcn_mfma_f32_16x16x32_bf16(__builtin_bit_cast(bf16x8, a), __builtin_bit_cast(bf16x8, b0), O00, 0, 0, 0);
            O01 = __builtin_amdgcn_mfma_f32_16x16x32_bf16(__builtin_bit_cast(bf16x8, a), __builtin_bit_cast(bf16x8, b1), O01, 0, 0, 0);
            O10 = __builtin_amdgcn_mfma_f32_16x16x32_bf16(__builtin_bit_cast(bf16x8, a2), __builtin_bit_cast(bf16x8, b0), O10, 0, 0, 0);
            O11 = __builtin_amdgcn_mfma_f32_16x16x32_bf16(__builtin_bit_cast(bf16x8, a2), __builtin_bit_cast(bf16x8, b1), O11, 0, 0, 0); }
        bf16x8 av0, av1, bv0, bv1;
#pragma unroll
        for (int j8 = 0; j8 < 8; ++j8) { const int sv = 16 * (j8 >> 2) + 4 * q + (j8 & 3);
            av0[j8] = (short)*(const LAS u16*)(Vp + sv * 272 + dv0 * 2); av1[j8] = (short)*(const LAS u16*)(Vp + sv * 272 + dv1 * 2);
            bv0[j8] = (short)*(const LAS u16*)(Vp + (8 * q + j8) * 272 + dv0 * 2); bv1[j8] = (short)*(const LAS u16*)(Vp + (8 * q + j8) * 272 + dv1 * 2); }
        O00 = __builtin_amdgcn_mfma_f32_16x16x32_bf16(av0, __builtin_bit_cast(bf16x8, bp0), O00, 0, 0, 0);
        O01 = __builtin_amdgcn_mfma_f32_16x16x32_bf16(av0, __builtin_bit_cast(bf16x8, bp1), O01, 0, 0, 0);
        O10 = __builtin_amdgcn_mfma_f32_16x16x32_bf16(av1, __builtin_bit_cast(bf16x8, bp0), O10, 0, 0, 0);
        O11 = __builtin_amdgcn_mfma_f32_16x16x32_bf16(av1, __builtin_bit_cast(bf16x8, bp1), O11, 0, 0, 0);
        { u16* op = Zg + (size_t)rowof(cc, r) * 1024 + 32 * pw + 4 * q;
          u32x2 o; o.x = cvt_pk_bf16(O00[0], O00[1]); o.y = cvt_pk_bf16(O00[2], O00[3]); *(u32x2*)op = o;
          o.x = cvt_pk_bf16(O01[0], O01[1]); o.y = cvt_pk_bf16(O01[2], O01[3]); *(u32x2*)(op + 16 * rstr) = o;
          o.x = cvt_pk_bf16(O10[0], O10[1]); o.y = cvt_pk_bf16(O10[2], O10[3]); *(u32x2*)(op + 16) = o;
          o.x = cvt_pk_bf16(O11[0], O11[1]); o.y = cvt_pk_bf16(O11[2], O11[3]); *(u32x2*)(op + 16 * rstr + 16) = o; }
#pragma unroll
        for (int i = 0; i < 8; ++i) { const bf16x8 a = *(const LAS bf16x8*)(Kt + (16 * i + r) * 80 + q * 16);
            const f32x4 e = *(const LAS f32x4*)(Eend + 16 * i + 4 * q);
            S0[i] = __builtin_amdgcn_mfma_f32_16x16x32_bf16(a, bv0, S0[i] * e, 0, 0, 0);
            S1[i] = __builtin_amdgcn_mfma_f32_16x16x32_bf16(a, bv1, S1[i] * e, 0, 0, 0); }
    };
    __syncthreads();
    if (prepw) {
        SC_LOAD(0, zcA, qcA, zcB, qcB, vc0, vc1); SC_PREP(0, zcA, qcA, zcB, qcB, vc0, vc1); SC_LOAD(1, znA, qnA, znB, qnB, vn0, vn1); SC_LOAD(2, zcA, qcA, zcB, qcB, vc0, vc1);
        SC_BAR();
        for (int cc = 0; cc < 72; cc += 2) {
            SC_PREP(1, znA, qnA, znB, qnB, vn0, vn1); if (cc + 3 < 72) SC_LOAD(cc + 3, znA, qnA, znB, qnB, vn0, vn1);
            SC_BAR();
            if (cc + 2 < 72) { SC_PREP(0, zcA, qcA, zcB, qcB, vc0, vc1); if (cc + 4 < 72) SC_LOAD(cc + 4, zcA, qcA, zcB, qcB, vc0, vc1); }
            SC_BAR();
        }
    } else {
        SC_BAR();
        for (int cc = 0; cc < 72; cc += 2) { mfma_stage(cc, 0); SC_BAR(); mfma_stage(cc + 1, 1); SC_BAR(); }
    }
    __syncthreads();
#undef SC_BAR
#undef SC_LOAD
#undef SC_PREP1
#undef SC_PREP
}

__device__ __forceinline__ void phase_scan_f3(const P& p, int l, int grp, LAS unsigned char* lds) {
    const int c = blockIdx.x, G = gridDim.x, bg = p.bg; const int nch = bg * 16;
#if (ONLY & 16)
    for (int ci = c; ci < nch; ci += G) scan_chain(p, l, ci, lds);
#endif
#if (ONLY & 64)
    int nw, wi;
    if (G > nch) { nw = G - nch; wi = c - nch; if (c < nch) return; } else { nw = G; wi = c; }
    { Gemm g; g.A = (const u16*)(p.ws + p.oDx); g.Bt = (const u16*)(p.ws + p.oTtx); g.lda = 2048; g.ldb = 2048; g.K = 2048;
      Sched S; S.nM = 8; S.nN = 1; S.nB = bg * 4; S.nw = nw; S.wi = wi; S.mode = 1; S.aTile = 256L * 2048 * 2; S.bTile = 0; S.aBatch = 0; S.bBatch = 256L * 2048 * 2; S.segmap = 0;
      EpiF3 E; E.G2 = (u16*)(p.ws + p.oG2); E.bias = p.b_four + l * 1024; E.scale = 1.f / sqrtf(2048.f * 256.f); E.rowbase = 0; E.Lp = 2048; E.t1024 = (const float*)(p.ws + p.oT1024);
      pg8::gemm_phase<EpiF3>(lds, g, S, E); }
    if (l < DEPTH - 1) { Gemm g; g.A = (const u16*)(p.ws + p.oDc); g.Bt = (const u16*)(p.ws + p.oTtc); g.lda = 512; g.ldb = 512; g.K = 512;
      Sched S; S.nM = 1; S.nN = 1; S.nB = bg * 4; S.nw = nw; S.wi = (wi + nw / 2) % nw; S.mode = 1; S.aTile = 0; S.bTile = 0; S.aBatch = 0; S.bBatch = 256L * 512 * 2; S.segmap = 0;
      EpiF3 E; E.G2 = (u16*)(p.ws + p.oG2); E.bias = p.b_four + l * 1024; E.scale = 1.f / sqrtf(256.f * 256.f); E.rowbase = bg * 2048; E.Lp = 256; E.t1024 = nullptr;
      pg8::gemm_phase<EpiF3>(lds, g, S, E); }
#endif
    { Gemm g; g.A = (const u16*)(p.ws + p.oH); g.Bt = (const u16*)(p.ws + p.oWinT) + (size_t)l * NIN * 1024; g.lda = 1024; g.ldb = 1024; g.K = 1024;
      Sched S; S.nM = bg * 8; S.nN = 4; S.nB = 1; S.nw = nw; S.wi = wi; S.mode = 0; S.aTile = 256L * 1024 * 2; S.bTile = 256L * 1024 * 2; S.aBatch = 0; S.bBatch = 0; S.segmap = 2;
      EpiIn E; E.V = (u16*)(p.ws + p.oV); E.ZF = (u16*)(p.ws + p.oZF); E.ZB = (u16*)(p.ws + p.oZB); E.Q = (u16*)(p.ws + p.oQ); E.G2 = (u16*)(p.ws + p.oG2); E.forced = 4; E.rowbase = 0; E.lbl = (const float*)(p.ws + p.oLbs) + l * 1024;
      pg8::gemm_phase<EpiIn>(lds, g, S, E); }
    { unsigned* cnt = (unsigned*)(p.ws + p.oBar) + XCD_BAR_WORDS + (l * p.ng + grp) * 64;
      asm volatile("s_waitcnt vmcnt(0) lgkmcnt(0)" ::: "memory"); __syncthreads();
      if (threadIdx.x == 0) { (void)xb_add(cnt, 1u); unsigned sp = 0; while (xb_ld(cnt) < (unsigned)nw) { __builtin_amdgcn_s_sleep(2); if (++sp > (1u << 22)) break; } }
      __syncthreads(); }
    { int nl = l, ngp = grp + 1; if (ngp == p.ng) { ngp = 0; ++nl; }
      if (nl < DEPTH) phase_norm(p, nl, ngp, wi, nw); }
}

__device__ __forceinline__ void phase_combine(const P& p, int l) {
    const int tid = tidx(), c = blockIdx.x, G = gridDim.x, bg = p.bg; const int Mg = (l == DEPTH - 1) ? bg * 2048 : bg * 2304;
    const u16* OF = (const u16*)(p.ws + p.oZF); const u16* OB = (const u16*)(p.ws + p.oZB); u16* G2 = (u16*)(p.ws + p.oG2);
    const int ch = (tid & 127) * 8; const float* hw = p.hn_w + l * 1024 + ch;
    float hv[8];
#pragma unroll
    for (int e = 0; e < 8; ++e) hv[e] = hw[e];
    int row = c * 4 + (tid >> 7);
    u32x4 a, b, gt, an, bn, gn;
    if (row < Mg) { a = __builtin_nontemporal_load((const u32x4*)(OF + (size_t)row * 1024 + ch)); b = __builtin_nontemporal_load((const u32x4*)(OB + (size_t)row * 1024 + ch)); gt = __builtin_nontemporal_load((const u32x4*)(G2 + (size_t)row * 2048 + ch)); }
    for (; row < Mg; row += G * 4) {
        const int nrow = row + G * 4;
        if (nrow < Mg) { an = __builtin_nontemporal_load((const u32x4*)(OF + (size_t)nrow * 1024 + ch)); bn = __builtin_nontemporal_load((const u32x4*)(OB + (size_t)nrow * 1024 + ch)); gn = __builtin_nontemporal_load((const u32x4*)(G2 + (size_t)nrow * 2048 + ch)); }
        float o[8], gg[8]; float ss = 0.f;
#pragma unroll
        for (int e = 0; e < 4; ++e) { o[2 * e] = bflo(a[e]) + bflo(b[e]); o[2 * e + 1] = bfhi(a[e]) + bfhi(b[e]); gg[2 * e] = bflo(gt[e]); gg[2 * e + 1] = bfhi(gt[e]); }
#pragma unroll
        for (int e = 0; e < 8; ++e) ss += o[e] * o[e];
#pragma unroll
        for (int m = 8; m >= 1; m >>= 1) ss += __shfl_xor(ss, m);
        const float rs = rsqrtf(ss * (1.f / 128.f) + 1e-6f);
        u32x4 wv;
#pragma unroll
        for (int e = 0; e < 4; ++e) wv[e] = cvt_pk_bf16(o[2 * e] * rs * hv[2 * e] * gg[2 * e], o[2 * e + 1] * rs * hv[2 * e + 1] * gg[2 * e + 1]);
        *(u32x4*)(G2 + (size_t)row * 2048 + ch) = wv;
        a = an; b = bn; gt = gn;
    }
}

__device__ __forceinline__ void phase_gemm_out(const P& p, int l, int grp, LAS unsigned char* lds) {
    const int c = blockIdx.x, G = gridDim.x, bg = p.bg;
    Gemm g; g.A = (const u16*)(p.ws + p.oG2); g.Bt = (const u16*)(p.ws + p.oWoutT) + (size_t)l * 1024 * 2048; g.lda = 2048; g.ldb = 2048; g.K = 2048;
    Sched S; S.nM = (l == DEPTH - 1) ? bg * 8 : bg * 9; S.nN = 4; S.nB = 1; S.nw = G; S.wi = c; S.mode = 0; S.aTile = 256L * 2048 * 2; S.bTile = 256L * 2048 * 2; S.aBatch = 0; S.bBatch = 0; S.segmap = 0;
    EpiOut E; E.xg = p.out + (size_t)grp * bg * 2048 * 1024; E.cg_ = (float*)(p.ws + p.oCtx) + (size_t)grp * bg * 256 * 1024; E.modl = (const float*)(p.ws + p.oMod) + (size_t)l * 17 * 3072; E.bg = bg; E.grp = grp;
    pg8::gemm_phase<EpiOut>(lds, g, S, E);
}

__device__ __forceinline__ void phase_final(const P& p) {
    const int tid = tidx(), lane = tid & 63, w = tid >> 6, c = blockIdx.x, G = gridDim.x;
    f32x4 fw[4], v[4], vn[4];
#pragma unroll
    for (int i = 0; i < 4; ++i) fw[i] = *(const f32x4*)(p.fnorm_w + i * 256 + lane * 4);
    int row = c * 8 + w;
    if (row < NB * SEQ) {
#pragma unroll
        for (int i = 0; i < 4; ++i) v[i] = __builtin_nontemporal_load((const f32x4*)(p.out + (size_t)row * 1024 + i * 256 + lane * 4)); }
    for (; row < NB * SEQ; row += G * 8) {
        float* src = p.out + (size_t)row * 1024; float ss = 0.f;
        const int nrow = row + G * 8;
        if (nrow < NB * SEQ) {
#pragma unroll
            for (int i = 0; i < 4; ++i) vn[i] = __builtin_nontemporal_load((const f32x4*)(p.out + (size_t)nrow * 1024 + i * 256 + lane * 4)); }
#pragma unroll
        for (int i = 0; i < 4; ++i) ss += v[i][0] * v[i][0] + v[i][1] * v[i][1] + v[i][2] * v[i][2] + v[i][3] * v[i][3];
#pragma unroll
        for (int o = 32; o >= 1; o >>= 1) ss += __shfl_xor(ss, o);
        const float rs = rsqrtf(ss * (1.f / 1024.f) + 1e-6f);
#pragma unroll
        for (int i = 0; i < 4; ++i) { const int col = i * 256 + lane * 4; f32x4 y = v[i] * rs * fw[i];
#ifdef SCRUB
            for (int e = 0; e < 4; ++e) if (!(fabsf(y[e]) < 1e30f)) y[e] = 30.f;
#endif
            __builtin_nontemporal_store(y, (f32x4*)(src + col)); }
#pragma unroll
        for (int i = 0; i < 4; ++i) v[i] = vn[i];
    }
}


#ifdef DBG
DI float wsum(float v) {
#pragma unroll
    for (int o = 32; o >= 1; o >>= 1) v += __shfl_xor(v, o);
    return v; }
DI float bfr(float v) { return bf2f(cvt_pk_bf16(v, 0.f) & 0xffffu); }
DI float dotHW(const u16* a, const u16* b, int n, int lane) { float s = 0.f; for (int k = lane; k < n; k += 64) s += bf2f(a[k]) * bf2f(b[k]); return wsum(s); }
__global__ void __launch_bounds__(NT) dbg_copy(P p) {
    const size_t gtid = (size_t)blockIdx.x * NT + threadIdx.x, gsz = (size_t)gridDim.x * NT; const size_t Mg = (size_t)p.bg * 2304;
    const u32x4* a = (const u32x4*)(p.ws + p.oZF); u32x4* da = (u32x4*)(p.ws + p.oDbg);
    for (size_t i = gtid; i < Mg * 1024 / 8; i += gsz) da[i] = a[i];
    const u32x4* b = (const u32x4*)(p.ws + p.oZB); u32x4* db = da + Mg * 1024 / 8;
    for (size_t i = gtid; i < Mg * 1024 / 8; i += gsz) db[i] = b[i];
    const u32x4* g = (const u32x4*)(p.ws + p.oG2); u32x4* dg = db + Mg * 1024 / 8;
    for (size_t i = gtid; i < Mg * 2048 / 8; i += gsz) dg[i] = g[i];
}
__global__ void __launch_bounds__(NT) dbg_check(P p) {
    __shared__ unsigned flsh[32];
    const int tid = threadIdx.x, lane = tid & 63, w = tid >> 6, bg = p.bg; const size_t Mg = (size_t)bg * 2304;
    unsigned* fl = flsh;
    if (tid < 32) fl[tid] = 0u;
    __syncthreads();
    const u16* H = (const u16*)(p.ws + p.oH); const u16* WinT = (const u16*)(p.ws + p.oWinT); const u16* V = (const u16*)(p.ws + p.oV); const u16* Q = (const u16*)(p.ws + p.oQ);
    const u16* ZFo = (const u16*)(p.ws + p.oZF); const u16* ZBo = (const u16*)(p.ws + p.oZB); const u16* G2 = (const u16*)(p.ws + p.oG2);
    const u16* dZF = (const u16*)(p.ws + p.oDbg); const u16* dZB = dZF + Mg * 1024; const u16* dG2 = dZB + Mg * 1024;
    const u16* WcsT = (const u16*)(p.ws + p.oWcsT); const u16* Wu = (const u16*)(p.ws + p.oWu); const u16* WpT = (const u16*)(p.ws + p.oWpT);
    const u16* Ttx = (const u16*)(p.ws + p.oTtx); const u16* Dx = (const u16*)(p.ws + p.oDx); const u16* WoutT = (const u16*)(p.ws + p.oWoutT);
    const float* mod = (const float*)(p.ws + p.oMod); const float* lbs = (const float*)(p.ws + p.oLbs);
#define CHKS(idx, fast, ref, tol, scl) do { const float f_ = (fast), r_ = (ref); if (lane == 0 && !(fabsf(f_ - r_) <= (tol) * (fabsf(r_) + (scl)))) atomicOr((unsigned*)&fl[idx], 1u); } while (0)
#define CHK(idx, fast, ref, tol) CHKS(idx, fast, ref, tol, 0.05f)
    for (int s = w; s < 16; s += 8) {
        const int si = s & 3, sj = s >> 2; const int row = si == 0 ? 0 : (si == 1 ? 4099 : (si == 2 ? bg * 2048 - 1 : bg * 2048 + 300)); const int col = sj == 0 ? 1 : (sj == 1 ? 130 : (sj == 2 ? 517 : 1023));
        { const int r = si == 3 ? 16 : si * 5, n = col * 3; float a = 0.f; for (int k = lane; k < 1024; k += 64) { const float cv = r < 16 ? p.c[r * 1024 + k] : p.c_ctx[k]; a += silu(cv) * p.w_ada[(size_t)k * 3072 + n]; }
          a = wsum(a) + p.b_ada[n]; CHK(1, mod[(size_t)r * 3072 + n], a, 1e-3f); }
        { const int n = col * 7, k = (row * 13) & 1023; CHK(2, bf2f(WinT[(size_t)n * 1024 + k]), bfr(p.w_in[(size_t)k * NIN + n]), 1e-6f); }
        { const float* src; int mr; if (row < bg * 2048) { src = p.x + (size_t)row * 1024; mr = row >> 11; } else { src = p.ctx + (size_t)(row - bg * 2048) * 1024; mr = 16; }
          float ss = 0.f, xv = 0.f; for (int k = lane; k < 1024; k += 64) { float v = src[k];
              if (row < bg * 2048) { const int t = row & 2047, i = k & 255; const float om = powf(10000.f, -(float)i / 256.f); const float pp = (float)(k < 512 ? (t >> 6) : (t & 63)); v += ((k >> 8) & 1) ? cosf(pp * om) : sinf(pp * om); }
              ss += v * v; if (k == col) xv = v; }
          ss = wsum(ss); xv = wsum(xv); const float y = xv * rsqrtf(ss / 1024.f + 1e-6f) * p.norm_w[col] * (1.f + mod[(size_t)mr * 3072 + 1024 + col]) + mod[(size_t)mr * 3072 + col];
          CHK(3, bf2f(H[(size_t)row * 1024 + col]), y, 1e-2f); }
        const u16* hrow = H + (size_t)row * 1024;
        { float d = dotHW(hrow, WinT + (size_t)col * 1024, 1024, lane); CHK(4, bf2f(V[(size_t)row * 1024 + col]), d, 1e-2f);
          d = dotHW(hrow, WinT + (size_t)(1024 + col) * 1024, 1024, lane); CHK(5, h2f(dZF[(size_t)row * 1024 + col]), d, 1e-2f);
          d = dotHW(hrow, WinT + (size_t)(2048 + col) * 1024, 1024, lane); CHK(5, h2f(dZB[(size_t)row * 1024 + col]), d, 1e-2f);
          d = dotHW(hrow, WinT + (size_t)(3072 + col) * 1024, 1024, lane); CHK(6, bf2f(Q[(size_t)row * 1024 + col]), silu(d), 1e-2f);
          d = dotHW(hrow, WinT + (size_t)(4096 + col) * 1024, 1024, lane); CHK(7, bf2f(dG2[(size_t)row * 2048 + col]), silu(d), 1e-2f);
          d = dotHW(hrow, WinT + (size_t)(6144 + col) * 1024, 1024, lane); CHK(7, bf2f(dG2[(size_t)row * 2048 + 1024 + col]), silu(d), 1e-2f); }
        const int g = si, n256 = col & 255, half = sj & 1, j = half * 256 + n256, cin = (row * 7 + 3) & 255;
        { float a = 0.f; for (int cp = lane; cp < 256; cp += 64) { const float th = (float)((cin * cp) & 255) / 128.f; a += (half ? sinpif(th) : cospif(th)) * p.w_four[((size_t)g * 256 + cp) * 256 + n256]; }
          a = wsum(a); CHK(8, bf2f(WcsT[((size_t)g * 512 + j) * 256 + cin]), a, 1e-2f); }
        { const int k = (row * 13) & 1023; const float d = dotHW(WcsT + ((size_t)g * 512 + j) * 256, Wu + (size_t)k * 1024 + g * 256, 256, lane); CHK(9, bf2f(WpT[((size_t)g * 512 + j) * 1024 + k]), d, 1e-2f); }
        if (row < bg * 2048) { const int bl = row >> 11, l = row & 2047; const float fast = bf2f(Ttx[(((size_t)(bl * 4 + g) * 256 + n256) * 2 + half) * 2048 + l]);
          const float d = dotHW(WpT + ((size_t)g * 512 + j) * 1024, hrow, 1024, lane); CHK(10, fast, d, 1e-2f);
          float a = 0.f; for (int ci = 0; ci < 256; ++ci) { const float u = dotHW(hrow, WinT + (size_t)(5120 + g * 256 + ci) * 1024, 1024, lane); float wc = 0.f;
              for (int cp = lane; cp < 256; cp += 64) { const float th = (float)((ci * cp) & 255) / 128.f; wc += (half ? sinpif(th) : cospif(th)) * p.w_four[((size_t)g * 256 + cp) * 256 + n256]; }
              a += u * wsum(wc); }
          CHKS(11, fast, a, 2e-2f, 10.f); }
        if (row < bg * 2048) { const int bl = row >> 11, lp = row & 2047; const u16* tt = Ttx + ((size_t)(bl * 4 + g) * 256 + n256) * 4096; const float sc = 1.f / sqrtf(2048.f * 256.f);
          const float gate = bf2f(dG2[(size_t)row * 2048 + 1024 + g * 256 + n256]), fast = bf2f(G2[(size_t)row * 2048 + 1024 + g * 256 + n256]), bb = p.b_four[g * 256 + n256];
          const float d = dotHW(Dx + (size_t)lp * 4096, tt, 4096, lane); CHK(14, fast, (d * sc + bb) * gate, 2e-2f);
          float a = 0.f; for (int l = lane; l < 2048; l += 64) { const float th = (float)((l * lp) & 2047) / 1024.f; a += cospif(th) * bf2f(tt[l]) - sinpif(th) * bf2f(tt[2048 + l]); }
          a = wsum(a); CHK(15, fast, (a * sc + bb) * gate, 2e-2f); }
        { const int hh = col >> 7; float ss = 0.f, ov = 0.f; for (int e = lane; e < 128; e += 64) { const float o = bf2f(ZFo[(size_t)row * 1024 + hh * 128 + e]) + bf2f(ZBo[(size_t)row * 1024 + hh * 128 + e]); ss += o * o; if (hh * 128 + e == col) ov = o; }
          ss = wsum(ss); ov = wsum(ov); const float y = ov * rsqrtf(ss / 128.f + 1e-6f) * p.hn_w[col] * bf2f(dG2[(size_t)row * 2048 + col]); CHK(16, bf2f(G2[(size_t)row * 2048 + col]), y, 2e-2f); }
        if (row < bg * 2048) { const float d = dotHW(G2 + (size_t)row * 2048, WoutT + (size_t)col * 2048, 2048, lane); const int t = row & 2047, i = col & 255; const float om = powf(10000.f, -(float)i / 256.f);
          const float pp = (float)(col < 512 ? (t >> 6) : (t & 63)); const float x0 = p.x[(size_t)row * 1024 + col] + (((col >> 8) & 1) ? cosf(pp * om) : sinf(pp * om));
          CHK(17, p.out[(size_t)row * 1024 + col], x0 + mod[(size_t)(row >> 11) * 3072 + 2048 + col] * d, 2e-2f); }
    }
    { const int dir = w & 1, sidx = w >> 1; const int bl = sidx & 1, hh = (sidx * 3 + 1) & 7, e = (sidx * 37 + 5) & 127; const int tgt = sidx < 2 ? 37 : (sidx == 2 ? 5 : -100);
      const u16* Zs = dir ? dZB : dZF; const u16* Oo = dir ? ZBo : ZFo; const float* lb = lbs + (dir * 4 + 0) * 1024 + hh * 128;
      float s0 = 0.f, s1 = 0.f, o = 0.f; const float l0 = 1.f - lb[lane], l1 = 1.f - lb[lane + 64]; int outrow = 0;
      for (int part = 0; part < 2; ++part) { const int Lp = part ? 2048 : 256, base = part ? bl * 2048 : bg * 2048 + bl * 256; int nsteps;
          if (part == 0) nsteps = tgt < 0 ? 101 : 256; else nsteps = tgt < 0 ? 0 : tgt + 1;
          for (int st = 0; st < nsteps; ++st) { const int row = base + (dir ? Lp - 1 - st : st); const size_t ro = (size_t)row * 1024 + hh * 128;
              const float z0 = h2f(Zs[ro + lane]), z1 = h2f(Zs[ro + lane + 64]); const float k0 = l0 / (1.f + expf(z0)), k1 = l1 / (1.f + expf(z1));
              const float f0 = fmaxf(1.f - k0, 1e-6f), f1 = fmaxf(1.f - k1, 1e-6f); const float v = bf2f(V[ro + e]);
              s0 = f0 * s0 + k0 * v; s1 = f1 * s1 + k1 * v; o = wsum(s0 * bf2f(Q[ro + lane]) + s1 * bf2f(Q[ro + lane + 64])); outrow = row; } }
      CHKS(12 + dir, bf2f(Oo[(size_t)outrow * 1024 + hh * 128 + e]), o, 2e-2f, 3.f); }
    __syncthreads();
    __shared__ unsigned cnt[4];
    if (tid < 4) cnt[tid] = 0u;
    __syncthreads();
    { unsigned c0 = 0, c1 = 0, c2 = 0;
      for (size_t i = tid; i < Mg * 1024; i += NT) { if (!(fabsf(bf2f(ZFo[i])) < 1e30f)) ++c0; if (!(fabsf(bf2f(ZBo[i])) < 1e30f)) ++c1; const size_t gi = (i >> 10) * 2048 + (i & 1023); if (!(fabsf(bf2f(G2[gi])) < 1e30f)) ++c2; }
      atomicAdd(&cnt[0], c0); atomicAdd(&cnt[1], c1); atomicAdd(&cnt[2], c2); }
    __syncthreads();
    int early = 0;
    for (int i = 1; i <= 13; ++i) if (fl[i]) early = 1;
    const int bitsA = early | ((cnt[0] | cnt[1]) ? 2 : 0) | (cnt[2] ? 4 : 0), bitsB = (fl[14] ? 1 : 0) | (fl[15] ? 2 : 0) | (fl[16] ? 4 : 0) | (fl[17] ? 8 : 0);
    const float val = 4.f * (float)bitsA;
    for (size_t i = tid; i < (size_t)NB * SEQ * DM; i += NT) p.out[i] = val;
    __syncthreads();
    if (tid == 0) p.out[0] = 100.f * (float)(1 + bitsB);
}
#endif


template <bool COOP>
__global__ void __launch_bounds__(NT, 2) fwd_kernel(P p0, int ph_lo, int ph_hi) {
    extern __shared__ __attribute__((aligned(16))) unsigned char shm[];
    LAS unsigned char* lds = (LAS unsigned char*)shm;
    const int nlp = DEPTH * p0.ng * 5, last = 2 + nlp;
    if (COOP) { if (threadIdx.x < 4) ((volatile LAS unsigned*)(lds + 131072))[threadIdx.x] = 0u;
        if (blockIdx.x == 0) { unsigned* bw = (unsigned*)(p0.ws + p0.oBar); for (int i = threadIdx.x; i < XCD_BAR_WORDS + 64 * 64; i += NT) __hip_atomic_store(bw + i, 0u, __ATOMIC_RELAXED, __HIP_MEMORY_SCOPE_AGENT); }
        __syncthreads(); }
    for (int ph = ph_lo; ph < ph_hi; ++ph) {
#ifdef SPIN_TYPE
        const int sty = ph == 0 ? 0 : (ph == 1 ? 1 : (ph == last ? 7 : 2 + (ph - 2) % 5));
        if (sty == SPIN_TYPE && __lane_id() == 0) ((volatile unsigned long long*)(p0.ws + p0.oModPart))[blockIdx.x * 8] = wall_clock64();
#endif
        P p = p0;
        { unsigned long long a = (unsigned long long)p.ws, b = (unsigned long long)p.out; asm volatile("" : "+s"(a), "+s"(b)); p.ws = (unsigned char*)a; p.out = (float*)b; }
#ifdef DBG
        if (ph == 0) phase_p0a(p, lds); else if (ph == 1) phase_p0b(p, lds); else if (ph == 2) phase_norm(p, 0, 0, blockIdx.x, gridDim.x); else if (ph == 3) phase_gemm_in(p, 0, lds);
        else if (ph == 5) phase_scan_f3(p, 0, 0, lds); else if (ph == 6) phase_combine(p, 0); else if (ph == 7) phase_gemm_out(p, 0, 0, lds);
        if (0) {}
#else
        if (ph == 0) { if (ONLY & 1) phase_p0a(p, lds); }
        else if (ph == 1) { if (ONLY & 2) phase_p0b(p, lds); }
        else if (ph == last) { if (ONLY & 4) phase_final(p); }
        else {
            const int k = ph - 2, lg = k / 5, sub = k % 5, l = lg / p.ng, grp = lg % p.ng;
            if (sub == 0) { if (lg > 0) continue; if (ONLY & 4) phase_norm(p, l, grp, blockIdx.x, gridDim.x); }
            else if (sub == 1) { if (ONLY & 8) phase_gemm_in(p, l, lds); }
            else if (sub == 2) { if (ONLY & 80) phase_scan_f3(p, l, grp, lds); }
            else if (sub == 3) { if (ONLY & 4) phase_combine(p, l); }
            else { if (ONLY & 32) phase_gemm_out(p, l, grp, lds); }
        }
#endif
        if (COOP) { if (ph + 1 < ph_hi) { if (ph == ph_lo) { cg::this_grid().sync(); xcd_barrier_post((unsigned*)(p0.ws + p0.oBar)); } else xcd_barrier((unsigned*)(p0.ws + p0.oBar), (volatile LAS unsigned*)(lds + 131072)); } }
#ifdef SPIN_TYPE
        if (sty == SPIN_TYPE) { const unsigned long long t0 = ((volatile unsigned long long*)(p0.ws + p0.oModPart))[blockIdx.x * 8]; const unsigned long long t1 = wall_clock64();
            while (wall_clock64() - t1 < t1 - t0) __builtin_amdgcn_s_sleep(8);
            cg::this_grid().sync(); }
#endif
    }
}

static size_t align_up(size_t v) { return (v + 4095) & ~(size_t)4095; }

extern "C" void kernel_launch(void* const* d_in, const int* in_sizes, int n_in, void* d_out, int out_size, void* d_ws, size_t ws_size, hipStream_t stream) {
    static int grid = 0;
    if (grid == 0) {
        int dev = 0, cus = 0;
        (void)hipGetDevice(&dev); (void)hipDeviceGetAttribute(&cus, hipDeviceAttributeMultiprocessorCount, dev);
        (void)hipFuncSetAttribute((const void*)fwd_kernel<true>, hipFuncAttributeMaxDynamicSharedMemorySize, LDS_BYTES);
        (void)hipFuncSetAttribute((const void*)fwd_kernel<false>, hipFuncAttributeMaxDynamicSharedMemorySize, LDS_BYTES);
        int per_cu = 0;
        (void)hipOccupancyMaxActiveBlocksPerMultiprocessor(&per_cu, (const void*)fwd_kernel<true>, NT, LDS_BYTES);
        if (per_cu < 1) per_cu = 1;
        grid = cus * 1;
        (void)hipGetLastError();
    }
    P p{};
    p.x = (const float*)d_in[0]; p.c = (const float*)d_in[1]; p.ctx = (const float*)d_in[2]; p.c_ctx = (const float*)d_in[3]; p.norm_w = (const float*)d_in[4];
    p.w_ada = (const float*)d_in[5]; p.b_ada = (const float*)d_in[6]; p.w_in = (const float*)d_in[7]; p.lower = (const float*)d_in[8]; p.hn_w = (const float*)d_in[9];
    p.w_four = (const float*)d_in[10]; p.b_four = (const float*)d_in[11]; p.w_out = (const float*)d_in[12]; p.fnorm_w = (const float*)d_in[13];
    p.out = (float*)d_out; p.ws = (unsigned char*)d_ws;
    auto layout = [&](int ng) -> size_t {
        const size_t bg = NB / ng, Mg = bg * 2304; size_t o = 0;
        p.ng = ng; p.bg = (int)bg;
        p.oWinT = o; o = align_up(o + (size_t)DEPTH * NIN * 1024 * 2);
        p.oWoutT = o; o = align_up(o + (size_t)DEPTH * 1024 * 2048 * 2);
        p.oWu = o; o = align_up(o + (size_t)DEPTH * 1024 * 1024 * 2);
        p.oWcsT = o; o = align_up(o + (size_t)16 * 512 * 256 * 2);
        p.oWpT = o; o = align_up(o + (size_t)DEPTH * 2048 * 1024 * 2);
        p.oDx = o; o = align_up(o + (size_t)2048 * 2048 * 2);
        p.oDc = o; o = align_up(o + (size_t)256 * 512 * 2);
        p.oPos = o; o = align_up(o + (size_t)2048 * 1024 * 4);
        p.oLbs = o; o = align_up(o + (size_t)2 * 4 * 1024 * 4);
        p.oModPart = o; o = align_up(o + (size_t)DEPTH * 8 * 17 * 3072 * 4);
        p.oMod = o; o = align_up(o + (size_t)DEPTH * 17 * 3072 * 4 + 64);
        p.oBar = o; o = align_up(o + (size_t)(XCD_BAR_WORDS + 64 * 64) * 4);
        p.oCtx = o; o = align_up(o + (size_t)NB * CTXL * DM * 4);
        p.oH = o; o = align_up(o + Mg * 1024 * 2);
        p.oV = o; o = align_up(o + Mg * 1024 * 2);
        p.oZF = o; o = align_up(o + Mg * 1024 * 2);
        p.oZB = o; o = align_up(o + Mg * 1024 * 2);
        p.oQ = o; o = align_up(o + Mg * 1024 * 2);
        p.oG2 = o; o = align_up(o + Mg * 2048 * 2);
        p.oTtx = o; o = align_up(o + bg * 4 * 256 * 2048 * 2);
        p.oH2 = o; o = align_up(o + Mg * 1024 * 2);
        p.oT1024 = o; o = align_up(o + bg * 1024 * 4);
        p.oTtc = o; o = align_up(o + bg * 4 * 256 * 512 * 2);
#ifdef DBG
        p.oDbg = o; o = align_up(o + Mg * 4096 * 2);
#endif
        return o;
    };
#ifdef DBG
    size_t need = layout(4);
#else
    size_t need = layout(2);
    if (need > ws_size) need = layout(4);
#endif
    if (need > ws_size) { fprintf(stderr, "kernel_launch: workspace too small (%zu < %zu)\n", ws_size, need); return; }
#ifdef DBG
    const int nph = 9;
#else
    const int nph = 2 + DEPTH * p.ng * 5 + 1;
#endif
#ifndef MULTI_LAUNCH
    int lo = 0, hi = nph;
    void* args[] = {&p, &lo, &hi};
    hipError_t e = hipLaunchCooperativeKernel((const void*)fwd_kernel<true>, dim3(grid), dim3(NT), args, LDS_BYTES, stream);
    if (e != hipSuccess) fprintf(stderr, "cooperative launch failed: %s (grid %d)\n", hipGetErrorString(e), grid);
#else
#ifdef DBG
    for (int ph = 0; ph < nph; ++ph) {
        if (ph == 4) hipLaunchKernelGGL(dbg_copy, dim3(grid), dim3(NT), 0, stream, p);
        else if (ph == 8) hipLaunchKernelGGL(dbg_check, dim3(1), dim3(NT), 0, stream, p);
        else hipLaunchKernelGGL(fwd_kernel<false>, dim3(grid), dim3(NT), LDS_BYTES, stream, p, ph, ph + 1);
    }
#else
    for (int ph = 0; ph < nph; ++ph) hipLaunchKernelGGL(fwd_kernel<false>, dim3(grid), dim3(NT), LDS_BYTES, stream, p, ph, ph + 1);
#endif
#endif
}
```
